# Optimizing an MI355X kernel written in HIP

```python
import math
import jax
import jax.numpy as jnp
from jax import lax
import numpy as np

D_MODEL = 2048
BATCH = 2
SEQ = 8192
DEPTH = 1
DEC_BATCH = 32
DEC_SEQ = 4
PAST_LEN = 16384
PAGE_SIZE = 128

D_MIX = D_MODEL
D_ATTN = D_MIX // 2
D_SSM = D_MIX - D_ATTN
HEAD_DIM = 64
N_HEADS = D_ATTN // HEAD_DIM
SSM_CH = 16
SSM_GROUPS = D_SSM // SSM_CH
SSM_STATE = 64
DILATED = ((128, 1), (512, 4), (2048, 16))
W_MAX = 2048
BLK = 128
NUM_BUCKETS = 32
MAX_DISTANCE = W_MAX
ATTN_SCALE = HEAD_DIM ** -0.5
LN_EPS = 1e-5
DN_ALPHA = (2 * DEPTH) ** 0.25
DN_BETA = (8 * DEPTH) ** -0.25
N_PROJ = 4 * D_ATTN + 2 * D_SSM

kernel_name = 'hymba_longnet_s5_deepnorm_step'


def t5_bucket(dist):
    exact = NUM_BUCKETS // 2
    d_f = jnp.maximum(dist, 1).astype(jnp.float32)
    large = exact + (jnp.log(d_f / exact) / math.log(MAX_DISTANCE / exact)
                     * (NUM_BUCKETS - exact)).astype(jnp.int32)
    large = jnp.minimum(large, NUM_BUCKETS - 1)
    return jnp.where(dist < exact, dist, large)


def pattern_bias(rel_bias, dil, kper):
    dist = jnp.arange(kper + 1, dtype=jnp.int32) * dil
    return rel_bias[t5_bucket(dist)].astype(jnp.float32)


def band_dilated_attention(q, k, v, bias_k, dil, kper):
    b, l, h, e = q.shape
    span = BLK * dil
    lp = -(-l // span) * span
    nb = lp // span
    padw = ((0, 0), (0, lp - l), (0, 0), (0, 0))

    def blocks(t):
        return jnp.pad(t, padw).reshape(b, nb, BLK, dil, h, e)

    def with_prev(t):
        prev = jnp.pad(t, ((0, 0), (1, 0), (0, 0), (0, 0), (0, 0), (0, 0)))[:, :-1]
        return jnp.concatenate([prev, t], axis=2)

    qb = blocks(q)
    kb = with_prev(blocks(k))
    vb = with_prev(blocks(v))
    s = jnp.einsum('bnqrhe,bnkrhe->bnrhqk', qb, kb,
                   preferred_element_type=jnp.float32) * ATTN_SCALE
    rel = jnp.arange(BLK)[:, None] + BLK - jnp.arange(2 * BLK)[None, :]
    band = (rel >= 0) & (rel <= kper)
    in_cur = jnp.arange(2 * BLK) >= BLK
    valid = band[None] & ((jnp.arange(nb) > 0)[:, None, None] | in_cur[None, None, :])
    bias = jnp.transpose(bias_k[jnp.clip(rel, 0, kper)], (2, 0, 1))
    s = jnp.where(valid[None, :, None, None], s + bias, -jnp.inf)
    lse = jax.nn.logsumexp(s, axis=-1)
    p = jnp.exp(s - lse[..., None])
    o = jnp.einsum('bnrhqk,bnkrhe->bnqrhe', p, vb.astype(jnp.float32))
    o = o.reshape(b, lp, h, e)[:, :l]
    lse = jnp.transpose(lse, (0, 1, 4, 2, 3)).reshape(b, lp, h)[:, :l]
    return o, lse


def cached_dilated_attention(q, k_all, v_all, bias_k, dil, kper, buf):
    s_len = q.shape[1]
    idx = buf + jnp.arange(s_len)[:, None] - jnp.arange(kper + 1)[None, :] * dil
    valid = idx >= 0
    idx = jnp.maximum(idx, 0)
    kg = jnp.take(k_all, idx, axis=1)
    vg = jnp.take(v_all, idx, axis=1)
    s = jnp.einsum('bshe,bskhe->bhsk', q, kg, preferred_element_type=jnp.float32) * ATTN_SCALE
    s = jnp.where(valid[None, None], s + bias_k.T[None, :, None, :], -jnp.inf)
    lse = jax.nn.logsumexp(s, axis=-1)
    p = jnp.exp(s - lse[..., None])
    o = jnp.einsum('bhsk,bskhe->bshe', p, vg.astype(jnp.float32))
    return o, jnp.transpose(lse, (0, 2, 1))


def merge_by_denominator(outs, lses):
    w = jax.nn.softmax(jnp.stack(lses), axis=0)
    return jnp.sum(w[..., None] * jnp.stack(outs), axis=0)


def prompt_attention(q, k, v, rel_bias):
    outs, lses = [], []
    for win, dil in DILATED:
        kper = win // dil
        o, l = band_dilated_attention(q, k, v, pattern_bias(rel_bias, dil, kper), dil, kper)
        outs.append(o)
        lses.append(l)
    return merge_by_denominator(outs, lses)


def sample_attention(q, k, v, cache_k, cache_v, rel_bias):
    buf = cache_k.shape[1]
    k_all = jnp.concatenate([cache_k, k.astype(cache_k.dtype)], axis=1)
    v_all = jnp.concatenate([cache_v, v.astype(cache_v.dtype)], axis=1)
    outs, lses = [], []
    for win, dil in DILATED:
        kper = win // dil
        o, l = cached_dilated_attention(q, k_all, v_all, pattern_bias(rel_bias, dil, kper), dil, kper, buf)
        outs.append(o)
        lses.append(l)
    return merge_by_denominator(outs, lses)


def s5_ssm(u, x0_re, x0_im, lam_re, lam_im, log_dt, b_re, b_im, c_re, c_im, d_skip):
    bsz, l, _ = u.shape
    f32 = jnp.float32
    u = u.astype(f32).reshape(bsz, l, SSM_GROUPS, SSM_CH)
    lr = jnp.minimum(lam_re.astype(f32), -1e-4)
    li = lam_im.astype(f32)
    dt = jnp.exp(log_dt.astype(f32))[:, None]
    mag = jnp.exp(lr * dt)
    ab_re, ab_im = mag * jnp.cos(li * dt), mag * jnp.sin(li * dt)
    den = lr * lr + li * li
    inv_re, inv_im = lr / den, -li / den
    n_re, n_im = ab_re - 1.0, ab_im
    cf_re = n_re * inv_re - n_im * inv_im
    cf_im = n_re * inv_im + n_im * inv_re
    br, bi = b_re.astype(f32), b_im.astype(f32)
    bb_re = cf_re[..., None] * br - cf_im[..., None] * bi
    bb_im = cf_re[..., None] * bi + cf_im[..., None] * br
    bu_re = jnp.einsum('blgc,gnc->lbgn', u, bb_re)
    bu_im = jnp.einsum('blgc,gnc->lbgn', u, bb_im)
    bu_re = bu_re.at[0].add(ab_re * x0_re - ab_im * x0_im)
    bu_im = bu_im.at[0].add(ab_re * x0_im + ab_im * x0_re)
    a_re = jnp.broadcast_to(ab_re, (l, 1, SSM_GROUPS, SSM_STATE))
    a_im = jnp.broadcast_to(ab_im, (l, 1, SSM_GROUPS, SSM_STATE))

    def combine(e1, e2):
        a1r, a1i, b1r, b1i = e1
        a2r, a2i, b2r, b2i = e2
        return (a2r * a1r - a2i * a1i, a2r * a1i + a2i * a1r,
                a2r * b1r - a2i * b1i + b2r, a2r * b1i + a2i * b1r + b2i)

    _, _, xr, xi = lax.associative_scan(combine, (a_re, a_im, bu_re, bu_im), axis=0)
    y = (jnp.einsum('lbgn,gcn->blgc', xr, c_re.astype(f32))
         - jnp.einsum('lbgn,gcn->blgc', xi, c_im.astype(f32)))
    y = y + d_skip.astype(f32).reshape(SSM_GROUPS, SSM_CH) * u
    return y.reshape(bsz, l, D_SSM), xr[-1], xi[-1]


def layer_norm(x, g, b):
    xf = x.astype(jnp.float32)
    mu = jnp.mean(xf, axis=-1, keepdims=True)
    var = jnp.mean(jnp.square(xf - mu), axis=-1, keepdims=True)
    return ((xf - mu) * lax.rsqrt(var + LN_EPS) * g.astype(jnp.float32)
            + b.astype(jnp.float32)).astype(x.dtype)


def mixer_layer(x, attend, x0_re, x0_im, w_in, w_out, b_out, lam_re, lam_im, log_dt,
                b_re, b_im, c_re, c_im, d_skip, w_glu, b_glu, ln_g, ln_b):
    bsz, l, _ = x.shape
    h = jnp.einsum('bld,df->blf', x, w_in)
    q, k, v, g_attn, u, g_ssm = jnp.split(
        h, [D_ATTN, 2 * D_ATTN, 3 * D_ATTN, 4 * D_ATTN, 4 * D_ATTN + D_SSM], axis=-1)
    heads = lambda t: t.reshape(bsz, l, N_HEADS, HEAD_DIM)
    k_h, v_h = heads(k), heads(v)
    attn = attend(heads(q), k_h, v_h).reshape(bsz, l, D_ATTN).astype(x.dtype)
    y, s_re, s_im = s5_ssm(u, x0_re, x0_im, lam_re, lam_im, log_dt, b_re, b_im, c_re, c_im, d_skip)
    z = jax.nn.gelu(y)
    z = (z * jax.nn.sigmoid(z @ w_glu.astype(jnp.float32) + b_glu.astype(jnp.float32))).astype(x.dtype)
    branches = jnp.concatenate([attn * jax.nn.silu(g_attn), z * jax.nn.silu(g_ssm)], axis=-1)
    mix = jnp.einsum('blf,fd->bld', branches, w_out) + b_out
    out = layer_norm(DN_ALPHA * x + mix, ln_g, ln_b)
    return out, k_h, v_h, s_re, s_im


def setup_inputs(seed: int = 0) -> dict:
    key = jax.random.key(seed)
    ks = jax.random.split(key, 24)
    nrm = lambda k, shape, s: jax.random.normal(k, shape, jnp.float32) * s
    cache_len = min(W_MAX, PAST_LEN)
    g, n = SSM_GROUPS, SSM_STATE
    lam_im0 = jnp.pi * jnp.arange(n, dtype=jnp.float32)
    return {
        'x_prompt': nrm(ks[0], (BATCH, SEQ, D_MODEL), 1.0),
        'x_sample': nrm(ks[1], (DEC_BATCH, DEC_SEQ, D_MODEL), 1.0),
        'cache_k': nrm(ks[2], (DEPTH, DEC_BATCH, cache_len, N_HEADS, HEAD_DIM), 1.0),
        'cache_v': nrm(ks[3], (DEPTH, DEC_BATCH, cache_len, N_HEADS, HEAD_DIM), 1.0),
        'state_ssm_re': nrm(ks[4], (DEPTH, DEC_BATCH, g, n), 0.1),
        'state_ssm_im': nrm(ks[5], (DEPTH, DEC_BATCH, g, n), 0.1),
        'w_in': nrm(ks[6], (DEPTH, D_MODEL, N_PROJ), D_MODEL ** -0.5),
        'w_out': nrm(ks[7], (DEPTH, D_MIX, D_MODEL), D_MIX ** -0.5 * DN_BETA),
        'b_out': nrm(ks[8], (DEPTH, D_MODEL), 0.01),
        'rel_bias': nrm(ks[9], (NUM_BUCKETS, N_HEADS), 0.5),
        'lam_re': -0.5 + nrm(ks[10], (DEPTH, g, n), 0.01),
        'lam_im': lam_im0 + nrm(ks[11], (DEPTH, g, n), 0.01),
        'log_dt': jax.random.uniform(ks[12], (DEPTH, g), jnp.float32,
                                     minval=math.log(1e-3), maxval=math.log(1e-1)),
        'b_re': nrm(ks[13], (DEPTH, g, n, SSM_CH), (2 * SSM_CH) ** -0.5),
        'b_im': nrm(ks[14], (DEPTH, g, n, SSM_CH), (2 * SSM_CH) ** -0.5),
        'c_re': nrm(ks[15], (DEPTH, g, SSM_CH, n), n ** -0.5),
        'c_im': nrm(ks[16], (DEPTH, g, SSM_CH, n), n ** -0.5),
        'd_skip': nrm(ks[17], (DEPTH, D_SSM), 1.0),
        'w_glu': nrm(ks[18], (DEPTH, D_SSM, D_SSM), D_SSM ** -0.5),
        'b_glu': nrm(ks[19], (DEPTH, D_SSM), 0.01),
        'ln_g': 1.0 + nrm(ks[20], (DEPTH, D_MODEL), 0.01),
        'ln_b': nrm(ks[21], (DEPTH, D_MODEL), 0.01),
    }


def reference(x_prompt, x_sample, cache_k, cache_v, state_ssm_re, state_ssm_im, w_in, w_out, b_out,
              rel_bias, lam_re, lam_im, log_dt, b_re, b_im, c_re, c_im, d_skip, w_glu, b_glu, ln_g, ln_b):
    xp, xs = x_prompt, x_sample
    keep = min(W_MAX, x_prompt.shape[1])
    kp_l, vp_l, srp_l, sip_l = [], [], [], []
    ks_l, vs_l, srs_l, sis_l = [], [], [], []
    for layer in range(DEPTH):
        params = (w_in[layer], w_out[layer], b_out[layer], lam_re[layer], lam_im[layer], log_dt[layer],
                  b_re[layer], b_im[layer], c_re[layer], c_im[layer], d_skip[layer], w_glu[layer],
                  b_glu[layer], ln_g[layer], ln_b[layer])
        zeros = jnp.zeros((xp.shape[0], SSM_GROUPS, SSM_STATE), jnp.float32)
        xp, kp, vp, srp, sip = mixer_layer(
            xp, lambda q, k, v: prompt_attention(q, k, v, rel_bias), zeros, zeros, *params)
        ck, cv = cache_k[layer], cache_v[layer]
        xs, kn, vn, srs, sis = mixer_layer(
            xs, lambda q, k, v, ck=ck, cv=cv: sample_attention(q, k, v, ck, cv, rel_bias),
            state_ssm_re[layer].astype(jnp.float32), state_ssm_im[layer].astype(jnp.float32), *params)
        kp_l.append(kp[:, -keep:])
        vp_l.append(vp[:, -keep:])
        srp_l.append(srp)
        sip_l.append(sip)
        ks_l.append(kn)
        vs_l.append(vn)
        srs_l.append(srs)
        sis_l.append(sis)
    return (xp, xs, jnp.stack(kp_l), jnp.stack(vp_l), jnp.stack(srp_l), jnp.stack(sip_l),
            jnp.stack(ks_l), jnp.stack(vs_l), jnp.stack(srs_l), jnp.stack(sis_l))
```

```cpp
#include <hip/hip_runtime.h>
#include <cstdio>
#include <cstdint>
#include <cmath>
namespace pg8 {
#define PG8_LAS __attribute__((address_space(3)))
typedef unsigned short bf16_t;
typedef short bf16x8 __attribute__((ext_vector_type(8)));
typedef float f32x4 __attribute__((ext_vector_type(4)));
typedef unsigned u32x4 __attribute__((ext_vector_type(4)));
constexpr int BM = 256, BK = 64, HALF = 128, HTB = HALF * BK * 2  , STAGE_BYTES = 8 * HTB, NXCD = 8, WGM = 8;

__host__ __device__ __forceinline__ int lds_byte(int r, int c) { const int st = (r >> 4) * 2 + (c >> 5), rr = r & 15, cc = c & 31, ob = rr * 64 + cc * 2; return st * 1024 + (ob ^ (((ob >> 9) & 1) << 5)); }
__host__ __device__ __forceinline__ void stage_rc(int b, int& R, int& C) { const int st = b / 1024, sb = b % 1024, swz = sb ^ (((sb >> 9) & 1) << 5); R = (st >> 1) * 16 + swz / 64; C = (st & 1) * 32 + (swz % 64) / 2; }
__host__ __device__ __forceinline__ int perm32(int rho) { const int n = rho >> 4, i = rho & 15; return 8 * (i >> 2) + 4 * n + (i & 3); }

struct Unit { int pm, pn; };
struct Gemm { const bf16_t* A; const bf16_t* Bt; int M, N, K; };

struct StaticOrder {
    int nM, nN, nwg, G, c;
    __host__ __device__ void init(int M, int N, int G_, int c_) { nM = M / BM; nN = N / BM; nwg = nM * nN; G = G_; c = c_; }
    __host__ __device__ bool next(int i, Unit& u) const {
        const long L = (long)i * G + c; if (L >= nwg) return false;
        int wgid = (int)L; { const int q = nwg / NXCD, r = nwg % NXCD, xcd = wgid % NXCD, off = wgid / NXCD; wgid = (xcd < r ? xcd * (q + 1) : r * (q + 1) + (xcd - r) * q) + off; }
        const int nig = WGM * nN, gid = wgid / nig, fm = gid * WGM, gsz = (nM - fm) < WGM ? (nM - fm) : WGM;
        u.pm = fm + ((wgid % nig) % gsz); u.pn = (wgid % nig) / gsz; return true;
    }
    __device__ __forceinline__ void a_ready(const Unit&) const {}
    __device__ __forceinline__ void done(const Unit&) const {}
};

__device__ __forceinline__ unsigned cvt_pk_bf16(float lo, float hi) { unsigned r; asm volatile("v_cvt_pk_bf16_f32 %0, %1, %2" : "=v"(r) : "v"(lo), "v"(hi)); return r; }
__device__ __forceinline__ float silu_f(float v) { return v * __builtin_amdgcn_rcpf(1.0f + __expf(-v)); }
constexpr int M_P = 16384, M_S = 128, M_TOT = M_P + M_S, MR = 16640;
constexpr int DM = 2048, NPROJ = 6144, DA = 1024;
constexpr float QSCALE = 0.125f * 1.4426950408889634f;
typedef float f32x2 __attribute__((ext_vector_type(2)));

struct EpiIn {
    static constexpr bool PERM = true, AFTER_DRAIN = false;
    bf16_t* H; float* kp; float* vp; float* ks; float* vs;
    __device__ __forceinline__ void operator()(const f32x4 (&acc)[2][2][4][2], const Unit& u, int wr, int wc, int fr, int fq) const {
        const int region = u.pn >> 2, colt = (u.pn & 3) * BM;
        bf16_t* base = H + (size_t)region * ((size_t)MR * DA);
        const int row0 = u.pm * BM + wr * 64 + fr, col0 = colt + wc * 32 + 8 * fq;
        float* fo_p = region == 1 ? kp : vp; float* fo_s = region == 1 ? ks : vs;
#pragma unroll
        for (int ai = 0; ai < 2; ++ai)
#pragma unroll
            for (int m = 0; m < 4; ++m) {
                const int row = row0 + ai * HALF + m * 16;
                bf16_t* rowp = base + (size_t)row * DA + col0;
                float* frow = nullptr;
                if (region == 1 || region == 2) {
                    if (row < M_P) { const int b = row >> 13, t = row & 8191; if (t >= 6144) frow = fo_p + ((size_t)(b * 2048 + (t - 6144))) * DA + col0; }
                    else if (row < M_TOT) frow = fo_s + (size_t)(row - M_P) * DA + col0;
                }
#pragma unroll
                for (int bj = 0; bj < 2; ++bj) {
                    f32x4 v0 = acc[ai][bj][m][0], v1 = acc[ai][bj][m][1];
                    if (region == 0) { v0 = v0 * QSCALE; v1 = v1 * QSCALE; }
                    if (region == 3 || region == 5) {
#pragma unroll
                        for (int e = 0; e < 4; ++e) { v0[e] = silu_f(v0[e]); v1[e] = silu_f(v1[e]); }
                    }
                    u32x4 w; w.x = cvt_pk_bf16(v0[0], v0[1]); w.y = cvt_pk_bf16(v0[2], v0[3]); w.z = cvt_pk_bf16(v1[0], v1[1]); w.w = cvt_pk_bf16(v1[2], v1[3]);
                    *(u32x4*)(rowp + bj * HALF) = w;
                    if (frow) { *(f32x4*)(frow + bj * HALF) = v0; *(f32x4*)(frow + bj * HALF + 4) = v1; }
                }
            }
    }
};
struct EpiGlu {
    static constexpr bool PERM = true, AFTER_DRAIN = false;
    const bf16_t* Z; const bf16_t* GS; const float* bias; bf16_t* BR;
    __device__ __forceinline__ void operator()(const f32x4 (&acc)[2][2][4][2], const Unit& u, int wr, int wc, int fr, int fq) const {
        const int row0 = u.pm * BM + wr * 64 + fr, col0 = u.pn * BM + wc * 32 + 8 * fq;
        f32x4 bv[2][2];
#pragma unroll
        for (int bj = 0; bj < 2; ++bj)
#pragma unroll
            for (int n = 0; n < 2; ++n) bv[bj][n] = *(const f32x4*)(bias + col0 + bj * HALF + 4 * n);
#pragma unroll
        for (int ai = 0; ai < 2; ++ai)
#pragma unroll
            for (int m = 0; m < 4; ++m) {
                const size_t row = (size_t)(row0 + ai * HALF + m * 16);
#pragma unroll
                for (int bj = 0; bj < 2; ++bj) {
                    const int col = col0 + bj * HALF;
                    const u32x4 zw = *(const u32x4*)(Z + row * 1024 + col), gw = *(const u32x4*)(GS + row * 1024 + col);
                    const f32x4 a0 = acc[ai][bj][m][0] + bv[bj][0], a1 = acc[ai][bj][m][1] + bv[bj][1];
                    float o[8];
#pragma unroll
                    for (int e = 0; e < 8; ++e) {
                        const unsigned zz = zw[e >> 1], gg = gw[e >> 1];
                        const float zf = __builtin_bit_cast(float, (e & 1) ? (zz & 0xffff0000u) : (zz << 16));
                        const float gf = __builtin_bit_cast(float, (e & 1) ? (gg & 0xffff0000u) : (gg << 16));
                        const float a = e < 4 ? a0[e & 3] : a1[e & 3];
                        o[e] = zf * __builtin_amdgcn_rcpf(1.0f + __expf(-a)) * gf;
                    }
                    u32x4 w; w.x = cvt_pk_bf16(o[0], o[1]); w.y = cvt_pk_bf16(o[2], o[3]); w.z = cvt_pk_bf16(o[4], o[5]); w.w = cvt_pk_bf16(o[6], o[7]);
                    *(u32x4*)(BR + row * 2048 + 1024 + col) = w;
                }
            }
    }
};
struct EpiOut {
    static constexpr bool PERM = false, AFTER_DRAIN = false;
    const float* xp; const float* xs; const float* bias; float* yp; float* ys; float alpha;
    __device__ __forceinline__ void operator()(const f32x4 (&acc)[2][2][4][2], const Unit& u, int wr, int wc, int fr, int fq) const {
        const int row0 = u.pm * BM + wr * 64 + fr, col0 = u.pn * BM + wc * 32 + 4 * fq;
        f32x4 bv[2][2];
#pragma unroll
        for (int bj = 0; bj < 2; ++bj)
#pragma unroll
            for (int n = 0; n < 2; ++n) bv[bj][n] = *(const f32x4*)(bias + col0 + bj * HALF + n * 16);
#pragma unroll
        for (int ai = 0; ai < 2; ++ai)
#pragma unroll
            for (int m = 0; m < 4; ++m) {
                const int row = row0 + ai * HALF + m * 16;
                if (row < M_TOT) {
                    const float* xr = row < M_P ? xp + (size_t)row * DM : xs + (size_t)(row - M_P) * DM;
                    float* yr = row < M_P ? yp + (size_t)row * DM : ys + (size_t)(row - M_P) * DM;
#pragma unroll
                    for (int bj = 0; bj < 2; ++bj)
#pragma unroll
                        for (int n = 0; n < 2; ++n) { const int col = col0 + bj * HALF + n * 16;
                            const f32x4 xv = *(const f32x4*)(xr + col);
                            *(f32x4*)(yr + col) = acc[ai][bj][m][n] + bv[bj][n] + xv * alpha; }
                }
            }
    }
};
template <class Epi, class Sched, bool ALIGN_EPI = false, bool SP2 = false>
__device__ __forceinline__ void gemm_phase(PG8_LAS unsigned char* lds, const Gemm g, const Sched& S, const Epi& E) {
    const int tid = threadIdx.x, wid = __builtin_amdgcn_readfirstlane(tid >> 6), lane = tid & 63, wr = wid >> 2, wc = wid & 3, fr = lane & 15, fq = lane >> 4;
    const int K = g.K, nt = K / BK;
    unsigned voffA[2], voffB[2];
#pragma unroll
    for (int i = 0; i < 2; ++i) { int R, C; stage_rc(tid * 16 + i * 8192, R, C); const int Rb = Epi::PERM ? ((R & ~31) + perm32(R & 31)) : R;
        voffA[i] = (unsigned)(R * K + C) * 2u; voffB[i] = (unsigned)(Rb * K + C) * 2u; }
    const size_t kstep = (size_t)(BK * 2);
    const size_t hstep = (size_t)HALF * K * 2;
    const size_t tstep = 2 * hstep;
    const unsigned ldsw = (unsigned)wid * 1024u;
    const int aoff = lds_byte(wr * 64 + fr, fq * 8), boff = lds_byte(wc * 32 + fr, fq * 8);
#define PG8_SA(b, h) (((b) * 2 + (h)) * HTB)
#define PG8_SB(b, h) ((4 + (b) * 2 + (h)) * HTB)
#define PG8_STAGE(bufoff, gbase, voff) do { _Pragma("unroll") for (int _i = 0; _i < 2; ++_i) \
        __builtin_amdgcn_global_load_lds((const unsigned*)((const char*)(gbase) + (voff)[_i]), (PG8_LAS unsigned*)(lds + (bufoff) + ldsw + _i * 8192), 16, 0, 0); } while (0)
#define PG8_LDA(dst, b, h) do { _Pragma("unroll") for (int m = 0; m < 4; ++m) _Pragma("unroll") for (int k = 0; k < 2; ++k) dst[m][k] = *(const PG8_LAS bf16x8*)(lds + PG8_SA(b, h) + aoff + m * 2048 + k * 1024); } while (0)
#define PG8_LDB(dst, b, h) do { _Pragma("unroll") for (int n = 0; n < 2; ++n) _Pragma("unroll") for (int k = 0; k < 2; ++k) dst[n][k] = *(const PG8_LAS bf16x8*)(lds + PG8_SB(b, h) + boff + n * 2048 + k * 1024); } while (0)
#define PG8_MMA(ai, bj, At, Bt) do { __builtin_amdgcn_s_setprio(1); _Pragma("unroll") for (int m = 0; m < 4; ++m) _Pragma("unroll") for (int n = 0; n < 2; ++n) _Pragma("unroll") for (int k = 0; k < 2; ++k) \
        acc[ai][bj][m][n] = __builtin_amdgcn_mfma_f32_16x16x32_bf16(Bt[n][k], At[m][k], acc[ai][bj][m][n], 0, 0, 0); __builtin_amdgcn_s_setprio(0); } while (0)
#define PG8_WAIT_V(n) asm volatile("s_waitcnt vmcnt(" #n ")" ::: "memory")
#define PG8_WAIT_L(n) asm volatile("s_waitcnt lgkmcnt(" #n ")" ::: "memory")
#define PG8_BAR __builtin_amdgcn_s_barrier()
#define PG8_SCHED __builtin_amdgcn_sched_barrier(0)
    Unit cur, nxt; int ui = 0;
    if (!S.next(0, cur)) return;
    f32x4 acc[2][2][4][2];
#pragma unroll
    for (int a = 0; a < 2; ++a)
#pragma unroll
        for (int b = 0; b < 2; ++b)
#pragma unroll
            for (int m = 0; m < 4; ++m)
#pragma unroll
                for (int n = 0; n < 2; ++n) acc[a][b][m][n] = (f32x4){0.f, 0.f, 0.f, 0.f};
    bf16x8 At[4][2], B0[2][2], B1[2][2];
    const char* cA = (const char*)g.A + (size_t)cur.pm * tstep; const char* cB = (const char*)g.Bt + (size_t)cur.pn * tstep;
    S.a_ready(cur);
    if constexpr (SP2) {
        PG8_STAGE(PG8_SB(0, 0), cB, voffB); PG8_STAGE(PG8_SB(0, 1), cB + hstep, voffB); PG8_STAGE(PG8_SA(0, 0), cA, voffA); PG8_STAGE(PG8_SA(0, 1), cA + hstep, voffA);
        if (wr == 1) PG8_BAR;
        PG8_WAIT_V(2); PG8_BAR;
        PG8_STAGE(PG8_SB(1, 0), cB + kstep, voffB); PG8_STAGE(PG8_SA(1, 0), cA + kstep, voffA); PG8_STAGE(PG8_SB(1, 1), cB + hstep + kstep, voffB);
        PG8_WAIT_V(6); PG8_BAR;
    } else {
        PG8_STAGE(PG8_SB(0, 0), cB, voffB); PG8_STAGE(PG8_SA(0, 0), cA, voffA); PG8_STAGE(PG8_SB(0, 1), cB + hstep, voffB); PG8_STAGE(PG8_SA(0, 1), cA + hstep, voffA);
        if (wr == 1) PG8_BAR;
        PG8_WAIT_V(4); PG8_BAR;
        PG8_STAGE(PG8_SB(1, 0), cB + kstep, voffB); PG8_STAGE(PG8_SA(1, 0), cA + kstep, voffA); PG8_STAGE(PG8_SB(1, 1), cB + hstep + kstep, voffB);
        PG8_WAIT_V(6); PG8_BAR;
    }
    for (;;) {
        const bool has_next = S.next(ui + 1, nxt);
        const char* nA = has_next ? (const char*)g.A + (size_t)nxt.pm * tstep : cA; const char* nB = has_next ? (const char*)g.Bt + (size_t)nxt.pn * tstep : cB;
        for (int t = 0; t < nt; t += 2) {
            const bool last = (t == nt - 2);
            const char* a1 = cA + (size_t)(t + 1) * kstep;
            const char* a2 = last ? nA : cA + (size_t)(t + 2) * kstep; const char* b2 = last ? nB : cB + (size_t)(t + 2) * kstep;
            const char* a3 = a2 + kstep; const char* b3 = b2 + kstep;
            if (last && has_next) S.a_ready(nxt);
            if constexpr (SP2) {
            PG8_LDB(B0, 0, 0); PG8_LDB(B1, 0, 1); PG8_SCHED; PG8_LDA(At, 0, 0); PG8_STAGE(PG8_SA(1, 1), a1 + hstep, voffA);
            PG8_WAIT_V(8); PG8_WAIT_L(0); PG8_BAR; PG8_MMA(0, 0, At, B0); PG8_MMA(0, 1, At, B1); PG8_BAR; PG8_SCHED;
            PG8_LDA(At, 0, 1); PG8_STAGE(PG8_SB(0, 0), b2, voffB); PG8_STAGE(PG8_SB(0, 1), b2 + hstep, voffB); PG8_STAGE(PG8_SA(0, 0), a2, voffA);
            PG8_WAIT_V(8); PG8_WAIT_L(0); PG8_BAR; PG8_MMA(1, 0, At, B0); PG8_MMA(1, 1, At, B1); PG8_BAR; PG8_SCHED;
            PG8_LDB(B0, 1, 0); PG8_LDB(B1, 1, 1); PG8_SCHED; PG8_LDA(At, 1, 0); PG8_STAGE(PG8_SA(0, 1), a2 + hstep, voffA);
            PG8_WAIT_V(8); PG8_WAIT_L(0); PG8_BAR; PG8_MMA(0, 0, At, B0); PG8_MMA(0, 1, At, B1); PG8_BAR; PG8_SCHED;
            PG8_LDA(At, 1, 1); PG8_STAGE(PG8_SB(1, 0), b3, voffB); PG8_STAGE(PG8_SB(1, 1), b3 + hstep, voffB); PG8_STAGE(PG8_SA(1, 0), a3, voffA);
            PG8_WAIT_V(8); PG8_WAIT_L(0); PG8_BAR; PG8_MMA(1, 0, At, B0); PG8_MMA(1, 1, At, B1); PG8_BAR; PG8_SCHED;
            } else {
            PG8_LDB(B0, 0, 0); PG8_SCHED; PG8_LDA(At, 0, 0); PG8_STAGE(PG8_SA(1, 1), a1 + hstep, voffA);
            PG8_WAIT_L(8); PG8_BAR; PG8_WAIT_L(0); PG8_MMA(0, 0, At, B0); PG8_BAR; PG8_SCHED;
            PG8_LDB(B1, 0, 1); PG8_STAGE(PG8_SB(0, 0), b2, voffB);
            PG8_BAR; PG8_WAIT_L(0); PG8_MMA(0, 1, At, B1); PG8_BAR;
            PG8_LDA(At, 0, 1); PG8_STAGE(PG8_SA(0, 0), a2, voffA);
            PG8_BAR; PG8_WAIT_L(0); PG8_MMA(1, 0, At, B0); PG8_BAR; PG8_SCHED;
            PG8_STAGE(PG8_SB(0, 1), b2 + hstep, voffB);
            PG8_WAIT_V(6); PG8_BAR; PG8_MMA(1, 1, At, B1); PG8_BAR;
            PG8_LDB(B0, 1, 0); PG8_SCHED; PG8_LDA(At, 1, 0); PG8_STAGE(PG8_SA(0, 1), a2 + hstep, voffA);
            PG8_WAIT_L(8); PG8_BAR; PG8_WAIT_L(0); PG8_MMA(0, 0, At, B0); PG8_BAR; PG8_SCHED;
            PG8_LDB(B1, 1, 1); PG8_STAGE(PG8_SB(1, 0), b3, voffB);
            PG8_BAR; PG8_WAIT_L(0); PG8_MMA(0, 1, At, B1); PG8_BAR;
            PG8_LDA(At, 1, 1); PG8_STAGE(PG8_SA(1, 0), a3, voffA);
            PG8_BAR; PG8_WAIT_L(0); PG8_MMA(1, 0, At, B0); PG8_BAR; PG8_SCHED;
            PG8_STAGE(PG8_SB(1, 1), b3 + hstep, voffB);
            PG8_WAIT_V(6); PG8_BAR; PG8_MMA(1, 1, At, B1); PG8_BAR;
            }
        }
        if constexpr (ALIGN_EPI) { if (wr == 0) PG8_BAR; }
        if constexpr (!Epi::AFTER_DRAIN) { E(acc, cur, wr, wc, fr, fq); S.done(cur); }
        if (!has_next) break;
#pragma unroll
        for (int a = 0; a < 2; ++a)
#pragma unroll
            for (int b = 0; b < 2; ++b)
#pragma unroll
                for (int m = 0; m < 4; ++m)
#pragma unroll
                    for (int n = 0; n < 2; ++n) acc[a][b][m][n] = (f32x4){0.f, 0.f, 0.f, 0.f};
        cur = nxt; cA = nA; cB = nB; ++ui;
        if constexpr (ALIGN_EPI) { if (wr == 1) PG8_BAR; }
    }
    PG8_WAIT_V(0);
    if constexpr (!ALIGN_EPI) { if (wr == 0) PG8_BAR; }
    PG8_BAR;
    if constexpr (Epi::AFTER_DRAIN) { E.fused(acc, cur, wr, wc, fr, fq, lds, wid, lane); S.done(cur); }
#undef PG8_SA
#undef PG8_SB
#undef PG8_STAGE
#undef PG8_LDA
#undef PG8_LDB
#undef PG8_MMA
#undef PG8_WAIT_V
#undef PG8_WAIT_L
#undef PG8_BAR
#undef PG8_SCHED
}
}
#define GAS __attribute__((address_space(1)))
#define LAS __attribute__((address_space(3)))
typedef unsigned short bf16;
typedef unsigned v4u __attribute__((ext_vector_type(4)));
typedef float f32x4 __attribute__((ext_vector_type(4)));
typedef short bf16x8 __attribute__((ext_vector_type(8)));
typedef GAS unsigned gu32;
typedef GAS unsigned long long gu64;
#define RLX_AGENT __ATOMIC_RELAXED, __HIP_MEMORY_SCOPE_AGENT
#define LDS_WAIT() asm volatile("s_waitcnt lgkmcnt(0)" ::: "memory")
#define VM_WAIT() asm volatile("s_waitcnt vmcnt(0)" ::: "memory")
__device__ __forceinline__ unsigned long long rt() { return __builtin_amdgcn_s_memrealtime(); }
__device__ __forceinline__ unsigned f2bf(float f) { unsigned u = __builtin_bit_cast(unsigned, f); return (u + 0x7fffu + ((u >> 16) & 1u)) >> 16; }
__device__ __forceinline__ unsigned pk2(float lo, float hi) { return f2bf(lo) | (f2bf(hi) << 16); }

#define XB_TMO      128
#define XB_XCNT(j)  (256  + 64 * (j))
#define XB_XSUB(j)  (1280 + 64 * (j))
#define XB_XGEN(j)  (2304 + 64 * (j))
#define XB_TOP      3328
#define XB_TOPGEN   3392
#define XCD_BAR_WORDS 3456
#define XB_SPIN_CAP (1u << 18)

__device__ __forceinline__ unsigned xb_ld(unsigned* p)              { return __hip_atomic_load(p, __ATOMIC_RELAXED, __HIP_MEMORY_SCOPE_AGENT); }
__device__ __forceinline__ unsigned xb_add(unsigned* p, unsigned v) { return __hip_atomic_fetch_add(p, v, __ATOMIC_RELAXED, __HIP_MEMORY_SCOPE_AGENT); }
__device__ __forceinline__ unsigned xb_xcc_id() { return (unsigned)__builtin_amdgcn_s_getreg((3 << 11) | 20) & 0xFu; }
#define XB_SPIN(cond, bar) do { unsigned _sp = 0; while (cond) { __builtin_amdgcn_s_sleep(1); \
    if ((++_sp & 255u) == 0u) { if (xb_ld(&(bar)[XB_TMO])) break; if (_sp > XB_SPIN_CAP) { atomicAdd(&(bar)[XB_TMO], 1u); break; } } } } while (0)

struct XcdBarrier {
    unsigned* bar; unsigned x;
    volatile LAS unsigned* st;
};

__device__ __forceinline__ XcdBarrier xcd_barrier_post(unsigned* bar, volatile LAS unsigned* st) {
    XcdBarrier b; b.bar = bar; b.x = xb_xcc_id(); b.st = st;
    if (threadIdx.x == 0) (void)xb_add(&bar[XB_XCNT(b.x)], 1u);
    return b;
}
__device__ __forceinline__ void xcd_barrier_complete(unsigned* bar, unsigned x, unsigned& nloc, unsigned& nx) {
    const unsigned G = gridDim.x * gridDim.y * gridDim.z;
    unsigned sum, cnt, mine, sp = 0u;
    for (;;) {
        sum = 0u; cnt = 0u; mine = 0u;
#pragma unroll
        for (unsigned j = 0; j < 16; ++j) { const unsigned c = xb_ld(&bar[XB_XCNT(j)]); sum += c; cnt += (c > 0u) ? 1u : 0u; mine = (j == x) ? c : mine; }
        if (sum == G) break;
        __builtin_amdgcn_s_sleep(1);
        if ((++sp & 255u) == 0u) { if (xb_ld(&bar[XB_TMO])) break; if (sp > XB_SPIN_CAP) { atomicAdd(&bar[XB_TMO], 1u); break; } }
    }
    nloc = mine > 0u ? mine : 1u; nx = cnt > 0u ? cnt : 1u;
}

__device__ __forceinline__ void xcd_barrier(const XcdBarrier& b) {
    asm volatile("s_waitcnt vmcnt(0)" ::: "memory");
    __syncthreads();
    if (threadIdx.x == 0) {
        unsigned* bar = b.bar;
        __builtin_amdgcn_s_waitcnt(0);
        unsigned nloc = b.st[0], nx = b.st[1];
        if (nloc == 0u) { xcd_barrier_complete(bar, b.x, nloc, nx); b.st[0] = nloc; b.st[1] = nx; }
        const unsigned old = xb_add(&bar[XB_XSUB(b.x)], 1u);
        const unsigned gen = old / nloc;
        if (old + 1u == (gen + 1u) * nloc) {
            __builtin_amdgcn_fence(__ATOMIC_RELEASE, "agent");
            asm volatile("s_waitcnt vmcnt(0)" ::: "memory");
            const unsigned og = xb_add(&bar[XB_TOP], 1u);
            const unsigned tg = og / nx;
            if (og + 1u == (tg + 1u) * nx) xb_add(&bar[XB_TOPGEN], 1u);
            else XB_SPIN(xb_ld(&bar[XB_TOPGEN]) == tg, bar);
            __builtin_amdgcn_fence(__ATOMIC_ACQUIRE, "agent");
            xb_add(&bar[XB_XGEN(b.x)], 1u);
            asm volatile("s_waitcnt vmcnt(0)" ::: "memory");
        } else {
            XB_SPIN(xb_ld(&bar[XB_XGEN(b.x)]) == gen, bar);
            __builtin_amdgcn_fence(__ATOMIC_ACQUIRE, "agent");
            asm volatile("s_waitcnt vmcnt(0)" ::: "memory");
        }
    }
    __syncthreads();
}
__device__ __forceinline__ float bf2f(unsigned short h) { return __builtin_bit_cast(float, (unsigned)h << 16); }
using pg8::M_P; using pg8::M_S; using pg8::M_TOT; using pg8::MR; using pg8::DM; using pg8::NPROJ; using pg8::DA;
constexpr int NWAVES = 8;
constexpr int SEQ = 8192, NHEAD = 16, HD = 64, NGRP = 64, NST = 64, NCH = 16;
constexpr float LN_EPS = 1e-5f;
constexpr float DN_ALPHA = 1.189207115002721f;
constexpr size_t MiB = 1u << 20;
constexpr size_t WS_CTL = 0, CTL_ZERO_BYTES = 1 * MiB;
constexpr size_t WS_WIN = 2 * MiB;
constexpr size_t WS_WGLU = 26 * MiB;
constexpr size_t WS_WOUT = 28 * MiB;
constexpr size_t WS_SA = 36 * MiB;
constexpr size_t WS_BBAR = 37 * MiB;
constexpr size_t WS_XB = 64 * MiB;
constexpr size_t WS_H = 136 * MiB;
constexpr size_t WS_BR = 336 * MiB;
constexpr size_t WS_Z = 404 * MiB;
constexpr size_t WS_END = 440 * MiB;
constexpr size_t HREG = (size_t)MR * DA;
constexpr size_t O_YP = 0, O_YS = 33554432, O_KP = 33816576, O_VP = 38010880, O_SRP = 42205184, O_SIP = 42213376,
                 O_KS = 42221568, O_VS = 42352640, O_SRS = 42483712, O_SIS = 42614784, O_TOTAL = 42745856;
constexpr int CW_TMO = 0, CW_CODE = 1, CW_BAR = 4096, CW_Q = 16384;
constexpr int RING_OFF = 0, RING_BYTES = 131072;
constexpr int LDSCTL_OFF = 143360, MISC_OFF = LDSCTL_OFF + 320;
constexpr int LDS_BYTES = 147456;
struct Frame {
    LAS unsigned char* lds;
    volatile LAS unsigned* MISC;
    gu32* ctl;
    int tid, lane, wave;
    int vcu, G;
    const float* in[22]; float* out; unsigned char* ws;
};
__device__ __forceinline__ float wave_sum(float v) {
#pragma unroll
    for (int o = 1; o < 64; o <<= 1) v += __shfl_xor(v, o);
    return v;
}
__device__ __forceinline__ void p0_transpose_item(const float* W, int K, int N, bf16* WT, LAS float* scr, int item, int lane) {
    const int nblk = N / 32, kb = item / nblk, nb = item % nblk, k0 = 64 * kb, n0 = 32 * nb;
#pragma unroll 8
    for (int i = 0; i < 32; ++i) { const int kk = 2 * i + (lane >> 5); scr[kk * 33 + (lane & 31)] = W[(size_t)(k0 + kk) * N + n0 + (lane & 31)]; }
    LDS_WAIT(); asm volatile("" ::: "memory");
    const int c = lane & 7;
#pragma unroll
    for (int j = 0; j < 4; ++j) { const int n = (lane >> 3) + 8 * j; const LAS float* s = scr + (8 * c) * 33 + n;
        v4u o; o.x = pk2(s[0 * 33], s[1 * 33]); o.y = pk2(s[2 * 33], s[3 * 33]); o.z = pk2(s[4 * 33], s[5 * 33]); o.w = pk2(s[6 * 33], s[7 * 33]);
        *(GAS v4u*)(WT + (size_t)(n0 + n) * K + k0 + 8 * c) = o; }
    LDS_WAIT(); asm volatile("" ::: "memory");
}
__device__ __forceinline__ void sincos_d(double x, double& s, double& c) {
    const double TWO_PI = 6.283185307179586476925286766559;
    const double k = rint(x / TWO_PI);
    const double r = fma(-k, TWO_PI, x);
    const double y = r * 0.125, y2 = y * y;
    double sn = y * (1.0 - y2 / 6.0 * (1.0 - y2 / 20.0 * (1.0 - y2 / 42.0 * (1.0 - y2 / 72.0 * (1.0 - y2 / 110.0 * (1.0 - y2 / 156.0 * (1.0 - y2 / 210.0)))))));
    double cs = 1.0 - y2 / 2.0 * (1.0 - y2 / 12.0 * (1.0 - y2 / 30.0 * (1.0 - y2 / 56.0 * (1.0 - y2 / 90.0 * (1.0 - y2 / 132.0 * (1.0 - y2 / 182.0 * (1.0 - y2 / 240.0)))))));
#pragma unroll
    for (int i = 0; i < 3; ++i) { const double s2 = 2.0 * sn * cs, c2 = cs * cs - sn * sn; sn = s2; cs = c2; }
    s = sn; c = cs;
}
__device__ __forceinline__ void p0_prologue(Frame& F) {
    LAS float* scr = (LAS float*)(F.lds + RING_OFF + F.wave * 16384);
    const int gw = F.vcu * NWAVES + F.wave, NGW = F.G * NWAVES;
    constexpr int I_IN = (DM / 64) * (NPROJ / 32), I_GLU = (1024 / 64) * (1024 / 32), I_OUT = (DM / 64) * (DM / 32);
    constexpr int NITEMS = I_IN + I_GLU + I_OUT;
    for (int it = gw; it < NITEMS; it += NGW) {
        int r = it;
        if (r < I_IN) { p0_transpose_item(F.in[6], DM, NPROJ, (bf16*)(F.ws + WS_WIN), scr, r, F.lane); continue; } r -= I_IN;
        if (r < I_GLU) { p0_transpose_item(F.in[18], 1024, 1024, (bf16*)(F.ws + WS_WGLU), scr, r, F.lane); continue; } r -= I_GLU;
        p0_transpose_item(F.in[7], DM, DM, (bf16*)(F.ws + WS_WOUT), scr, r, F.lane);
    }
    bf16* XB = (bf16*)(F.ws + WS_XB);
    for (int m = gw; m < MR; m += NGW) {
        GAS unsigned long long* o8 = (GAS unsigned long long*)(XB + (size_t)m * DM) + F.lane;
        if (m < M_TOT) {
            const float* xrow = m < M_P ? F.in[0] + (size_t)m * DM : F.in[1] + (size_t)(m - M_P) * DM;
            const GAS f32x4* xr = (const GAS f32x4*)xrow + F.lane;
#pragma unroll
            for (int j = 0; j < 8; ++j) { const f32x4 v = xr[64 * j]; o8[64 * j] = (unsigned long long)pk2(v.x, v.y) | ((unsigned long long)pk2(v.z, v.w) << 32); }
        } else {
#pragma unroll
            for (int j = 0; j < 8; ++j) o8[64 * j] = 0ull;
        }
    }
    const int gt = F.vcu * (NWAVES * 64) + F.tid;
    if (gt < NGRP * NST) {
        const int g = gt >> 6;
        const double lr = fmin((double)F.in[10][gt], -1e-4), li = (double)F.in[11][gt];
        const double dt = exp((double)F.in[12][g]);
        const double mag = exp(lr * dt); double sn, cs; sincos_d(li * dt, sn, cs);
        double ar = mag * cs, ai = mag * sn;
        const double den = lr * lr + li * li, inv_re = lr / den, inv_im = -li / den;
        const double n_re = ar - 1.0, n_im = ai;
        const double cf_re = n_re * inv_re - n_im * inv_im, cf_im = n_re * inv_im + n_im * inv_re;
        float* SA = (float*)(F.ws + WS_SA) + (size_t)gt * 8;
        SA[0] = (float)ar; SA[1] = (float)ai;
        double pr = ar, pi = ai;
        for (int i = 0; i < 10; ++i) { const double t = pr * pr - pi * pi; pi = 2.0 * pr * pi; pr = t; if (i == 4) { SA[2] = (float)pr; SA[3] = (float)pi; } }
        SA[4] = (float)pr; SA[5] = (float)pi; SA[6] = 0.f; SA[7] = 0.f;
        float* BB = (float*)(F.ws + WS_BBAR) + (size_t)gt * 32;
        const float* br = F.in[13] + (size_t)gt * 16; const float* bi = F.in[14] + (size_t)gt * 16;
        for (int c = 0; c < 16; ++c) { const double x = br[c], y = bi[c]; BB[2 * c] = (float)(cf_re * x - cf_im * y); BB[2 * c + 1] = (float)(cf_re * y + cf_im * x); }
    }
}
__device__ __forceinline__ int t5_bucket(int dist) {
    if (dist < 16) return dist;
    const float v = logf((float)dist / 16.0f) / 4.852030263919617f * 16.0f;
    const int large = 16 + (int)v;
    return large < 31 ? large : 31;
}
__device__ __forceinline__ float gelu_tanh(float y) {
    const float a = 0.7978845608028654f * (y + 0.044715f * y * y * y);
    const float t = __expf(2.0f * a);
    return 0.5f * y * (2.0f - 2.0f * __builtin_amdgcn_rcpf(t + 1.0f));
}
template <bool SAMPLE>
__device__ __forceinline__ void attn_simple_task(Frame& F, int task, const LAS int* bkt) {
    const int h = task & 15, rowi = task >> 4;
    const bf16* Hq = (const bf16*)(F.ws + WS_H);
    const size_t qrow = SAMPLE ? (size_t)(M_P + rowi) : (size_t)rowi;
    const int b = SAMPLE ? (rowi >> 2) : (rowi >> 13), t = SAMPLE ? (2048 + (rowi & 3)) : (rowi & 8191);
    unsigned qp[32];
    { const v4u* qv = (const v4u*)(Hq + qrow * DA + h * HD);
#pragma unroll
      for (int i = 0; i < 8; ++i) { const v4u w = qv[i]; qp[4 * i] = w.x; qp[4 * i + 1] = w.y; qp[4 * i + 2] = w.z; qp[4 * i + 3] = w.w; } }
    const bf16* Kb = Hq + HREG; const bf16* Vb = Hq + 2 * HREG;
    const float* ck = F.in[2]; const float* cv = F.in[3]; const float* kn = F.out + O_KS; const float* vn = F.out + O_VS;
    LAS float* lgs = (LAS float*)(F.lds + RING_OFF + 4096 + F.wave * 2048);
    float mx = -INFINITY;
#pragma unroll 1
    for (int i = 0; i < 7; ++i) {
        const int e = F.lane + 64 * i; float v = -INFINITY;
        if (e < 387) {
            const int p = e / 129, j = e - p * 129, d = p == 0 ? 1 : (p == 1 ? 4 : 16), kt = t - j * d;
            if (kt >= 0) {
                float dot = 0.f;
                if (SAMPLE) {
                    const float* kr = kt < 2048 ? ck + (((size_t)b * 2048 + kt) * NHEAD + h) * HD : kn + ((size_t)(b * 4 + kt - 2048)) * DA + h * HD;
#pragma unroll
                    for (int c = 0; c < 16; ++c) { const f32x4 kv = *(const f32x4*)(kr + 4 * c); const unsigned q0 = qp[2 * c], q1 = qp[2 * c + 1];
                        dot += __builtin_bit_cast(float, q0 << 16) * kv.x + __builtin_bit_cast(float, q0 & 0xffff0000u) * kv.y + __builtin_bit_cast(float, q1 << 16) * kv.z + __builtin_bit_cast(float, q1 & 0xffff0000u) * kv.w; }
                } else {
                    const v4u* kr = (const v4u*)(Kb + ((size_t)b * SEQ + kt) * DA + h * HD);
#pragma unroll
                    for (int c = 0; c < 8; ++c) { const v4u kw = kr[c];
#pragma unroll
                        for (int x = 0; x < 4; ++x) { const unsigned kk = kw[x], qq = qp[4 * c + x];
                            dot += __builtin_bit_cast(float, qq << 16) * __builtin_bit_cast(float, kk << 16) + __builtin_bit_cast(float, qq & 0xffff0000u) * __builtin_bit_cast(float, kk & 0xffff0000u); } }
                }
                v = dot + F.in[9][bkt[e] * NHEAD + h] * 1.4426950408889634f;
            }
            lgs[e] = v;
        }
        mx = fmaxf(mx, v);
    }
#pragma unroll
    for (int o = 1; o < 64; o <<= 1) mx = fmaxf(mx, __shfl_xor(mx, o));
    float sum = 0.f;
#pragma unroll 1
    for (int i = 0; i < 7; ++i) { const int e = F.lane + 64 * i; if (e < 387) { const float pr = exp2f(lgs[e] - mx); lgs[e] = pr; sum += pr; } }
    sum = wave_sum(sum);
    LDS_WAIT(); asm volatile("" ::: "memory");
    float acc = 0.f;
#pragma unroll 1
    for (int p = 0; p < 3; ++p) {
        const int d = p == 0 ? 1 : (p == 1 ? 4 : 16);
#pragma unroll 4
        for (int j = 0; j < 129; ++j) {
            const int kt = t - j * d;
            if (kt < 0) break;
            const float pe = lgs[p * 129 + j];
            float vv;
            if (SAMPLE) vv = kt < 2048 ? cv[(((size_t)b * 2048 + kt) * NHEAD + h) * HD + F.lane] : vn[((size_t)(b * 4 + kt - 2048)) * DA + h * HD + F.lane];
            else vv = bf2f(Vb[((size_t)b * SEQ + kt) * DA + h * HD + F.lane]);
            acc += pe * vv;
        }
    }
    LDS_WAIT(); asm volatile("" ::: "memory");
    const float ga = bf2f(Hq[3 * HREG + qrow * DA + h * HD + F.lane]);
    ((bf16*)(F.ws + WS_BR))[qrow * 2048 + h * HD + F.lane] = (bf16)f2bf(acc / sum * ga);
}
__device__ __forceinline__ void ssm_seq(Frame& F, int g, size_t rowbase, int L, const float* x0r, const float* x0i, float* outr, float* outi) {
    const int n = F.lane;
    const float* SA = (const float*)(F.ws + WS_SA) + (size_t)(g * NST + n) * 8;
    const float ar = SA[0], ai = SA[1];
    const float* BB = (const float*)(F.ws + WS_BBAR) + (size_t)(g * NST + n) * 32;
    float bbr[16], bbi[16], cre[16], cim[16];
#pragma unroll
    for (int c = 0; c < 16; ++c) { bbr[c] = BB[2 * c]; bbi[c] = BB[2 * c + 1]; cre[c] = F.in[15][(size_t)(g * NCH + c) * NST + n]; cim[c] = F.in[16][(size_t)(g * NCH + c) * NST + n]; }
    const float dsk = F.in[17][g * NCH + (n & 15)];
    float xr = x0r ? x0r[n] : 0.f, xi = x0i ? x0i[n] : 0.f;
    const bf16* U = (const bf16*)(F.ws + WS_H) + 4 * HREG; bf16* Z = (bf16*)(F.ws + WS_Z);
    for (int t = 0; t < L; ++t) {
        const size_t row = rowbase + t;
        const v4u* up = (const v4u*)(U + row * DA + g * NCH);
        const v4u u0 = up[0], u1 = up[1];
        float u[16];
#pragma unroll
        for (int c = 0; c < 4; ++c) { u[2 * c] = __builtin_bit_cast(float, u0[c] << 16); u[2 * c + 1] = __builtin_bit_cast(float, u0[c] & 0xffff0000u); u[8 + 2 * c] = __builtin_bit_cast(float, u1[c] << 16); u[9 + 2 * c] = __builtin_bit_cast(float, u1[c] & 0xffff0000u); }
        float bur = 0.f, bui = 0.f;
#pragma unroll
        for (int c = 0; c < 16; ++c) { bur += bbr[c] * u[c]; bui += bbi[c] * u[c]; }
        const float nxr = ar * xr - ai * xi + bur, nxi = ar * xi + ai * xr + bui;
        xr = nxr; xi = nxi;
        float yv = 0.f, uv = 0.f;
#pragma unroll
        for (int c = 0; c < 16; ++c) { const float s = wave_sum(cre[c] * xr - cim[c] * xi); if ((n & 15) == c) { yv = s; uv = u[c]; } }
        yv += dsk * uv;
        if (n < 16) Z[row * DA + g * NCH + n] = (bf16)f2bf(gelu_tanh(yv));
    }
    outr[n] = xr; outi[n] = xi;
}
__device__ __forceinline__ void ln_row_inplace(Frame& F, float* row) {
    GAS f32x4* xr = (GAS f32x4*)row + F.lane;
    f32x4 v[8]; float s = 0.f;
#pragma unroll
    for (int j = 0; j < 8; ++j) { v[j] = xr[64 * j]; s += (v[j].x + v[j].y) + (v[j].z + v[j].w); }
    const float mean = wave_sum(s) * (1.f / DM); float s2 = 0.f;
#pragma unroll
    for (int j = 0; j < 8; ++j) { v[j] = v[j] - mean; s2 += (v[j].x * v[j].x + v[j].y * v[j].y) + (v[j].z * v[j].z + v[j].w * v[j].w); }
    const float rstd = 1.f / sqrtf(wave_sum(s2) * (1.f / DM) + LN_EPS);
    const GAS f32x4* gp = (const GAS f32x4*)F.in[20] + F.lane; const GAS f32x4* bp = (const GAS f32x4*)F.in[21] + F.lane;
#pragma unroll
    for (int j = 0; j < 8; ++j) xr[64 * j] = v[j] * rstd * gp[64 * j] + bp[64 * j];
}
#ifndef MK_N_LAUNCHES
#define MK_N_LAUNCHES 6
#endif
constexpr int N_PHASES = 6;
constexpr int N_LAUNCHES = MK_N_LAUNCHES;
struct Args { const float* in[22]; float* out; unsigned char* ws; int ph_lo, ph_hi, li, pad; };
__global__ void __launch_bounds__(NWAVES * 64, 2) fwd_kernel(Args args) {
    extern __shared__ __attribute__((aligned(16))) unsigned char lds[];
    Frame F;
    F.lds = (LAS unsigned char*)lds;
    F.MISC = (volatile LAS unsigned*)(F.lds + MISC_OFF);
    F.tid = threadIdx.x; F.lane = F.tid & 63; F.wave = __builtin_amdgcn_readfirstlane(F.tid >> 6);
    F.G = gridDim.x; { const int bx = blockIdx.x; F.vcu = (F.G % 8 == 0) ? (bx % 8) * (F.G / 8) + bx / 8 : bx; }
    F.ws = args.ws; F.out = args.out;
#pragma unroll
    for (int i = 0; i < 22; ++i) F.in[i] = args.in[i];
    F.ctl = (gu32*)(F.ws + WS_CTL);
    for (int u = F.tid; u < (LDS_BYTES - LDSCTL_OFF) / 4; u += NWAVES * 64) ((LAS unsigned*)(F.lds + LDSCTL_OFF))[u] = 0u;
    __syncthreads();
    XcdBarrier bar; bar.bar = (unsigned*)(F.ctl + CW_BAR); bar.x = 0; bar.st = nullptr;
    if (N_LAUNCHES == 1) bar = xcd_barrier_post((unsigned*)(F.ctl + CW_BAR), F.MISC + 8);
    const int lo = args.ph_lo, hi = args.ph_hi;
#define IN(k) (lo <= (k) && (k) < hi)
#define BOTH(k) (IN(k) && IN((k) + 1))
#define GRID_BAR() do { if (N_LAUNCHES == 1) xcd_barrier(bar); } while (0)

    if (IN(0)) { p0_prologue(F); if (BOTH(0)) GRID_BAR(); }
    if (IN(1)) {
        pg8::Gemm g{(const pg8::bf16_t*)(F.ws + WS_XB), (const pg8::bf16_t*)(F.ws + WS_WIN), MR, NPROJ, DM};
        pg8::StaticOrder S; S.init(MR, NPROJ, F.G, (int)blockIdx.x);
        pg8::EpiIn E{(pg8::bf16_t*)(F.ws + WS_H), F.out + O_KP, F.out + O_VP, F.out + O_KS, F.out + O_VS};
        pg8::gemm_phase<pg8::EpiIn, pg8::StaticOrder, true, true>(F.lds + RING_OFF, g, S, E);
        if (BOTH(1)) GRID_BAR();
    }

    if (IN(2)) {
        LAS int* bkt = (LAS int*)(F.lds + RING_OFF);
        for (int e = F.tid; e < 387; e += NWAVES * 64) { const int p = e / 129, j = e - p * 129, d = p == 0 ? 1 : (p == 1 ? 4 : 16); bkt[e] = t5_bucket(j * d); }
        __syncthreads();
        const int gw = F.vcu * NWAVES + F.wave, NGW = F.G * NWAVES;
        if (F.wave == 0 && F.vcu < 2 * NGRP) { const int b = F.vcu >> 6, g = F.vcu & 63;
            ssm_seq(F, g, (size_t)b * SEQ, SEQ, nullptr, nullptr, F.out + O_SRP + (size_t)(b * NGRP + g) * NST, F.out + O_SIP + (size_t)(b * NGRP + g) * NST); }
        for (int task = gw; task < 32 * NGRP; task += NGW) { const int db = task >> 6, g = task & 63;
            ssm_seq(F, g, (size_t)M_P + db * 4, 4, F.in[4] + (size_t)task * NST, F.in[5] + (size_t)task * NST, F.out + O_SRS + (size_t)task * NST, F.out + O_SIS + (size_t)task * NST); }
        for (int task = gw; task < M_S * NHEAD; task += NGW) attn_simple_task<true>(F, task, bkt);
        for (int task = gw; task < M_P * NHEAD; task += NGW) attn_simple_task<false>(F, task, bkt);
        if (BOTH(2)) GRID_BAR();
    }
    if (IN(3)) {
        pg8::Gemm g{(const pg8::bf16_t*)(F.ws + WS_Z), (const pg8::bf16_t*)(F.ws + WS_WGLU), MR, 1024, 1024};
        pg8::StaticOrder S; S.init(MR, 1024, F.G, (int)blockIdx.x);
        pg8::EpiGlu E{(const pg8::bf16_t*)(F.ws + WS_Z), (const pg8::bf16_t*)(F.ws + WS_H) + 5 * HREG, F.in[19], (pg8::bf16_t*)(F.ws + WS_BR)};
        pg8::gemm_phase<pg8::EpiGlu, pg8::StaticOrder, true, true>(F.lds + RING_OFF, g, S, E);
        if (BOTH(3)) GRID_BAR();
    }
    if (IN(4)) {
        pg8::Gemm g{(const pg8::bf16_t*)(F.ws + WS_BR), (const pg8::bf16_t*)(F.ws + WS_WOUT), MR, DM, DM};
        pg8::StaticOrder S; S.init(MR, DM, F.G, (int)blockIdx.x);
        pg8::EpiOut E{F.in[0], F.in[1], F.in[8], F.out + O_YP, F.out + O_YS, DN_ALPHA};
        pg8::gemm_phase<pg8::EpiOut, pg8::StaticOrder, true, true>(F.lds + RING_OFF, g, S, E);
        if (BOTH(4)) GRID_BAR();
    }
    if (IN(5)) {
        const int gw = F.vcu * NWAVES + F.wave, NGW = F.G * NWAVES;
        for (int m = gw; m < M_TOT; m += NGW) ln_row_inplace(F, m < M_P ? F.out + O_YP + (size_t)m * DM : F.out + O_YS + (size_t)(m - M_P) * DM);
    }
#undef IN
#undef BOTH
}

extern "C" void kernel_launch(void* const* d_in, const int* in_sizes, int n_in, void* d_out, int out_size, void* d_ws, size_t ws_size, hipStream_t stream) {
    static int grid = 0;
    if (grid == 0) {
        if (n_in != 22 || (size_t)out_size != O_TOTAL || ws_size < WS_END) { fprintf(stderr, "kernel_launch: unexpected shapes: n_in %d out %d ws %zu\n", n_in, out_size, ws_size); grid = -1; return; }
        int dev = 0, cus = 0, per_cu = 0;
        if (hipGetDevice(&dev) != hipSuccess || hipDeviceGetAttribute(&cus, hipDeviceAttributeMultiprocessorCount, dev) != hipSuccess) { grid = -1; return; }
        if (hipFuncSetAttribute((const void*)fwd_kernel, hipFuncAttributeMaxDynamicSharedMemorySize, LDS_BYTES) != hipSuccess) { fprintf(stderr, "kernel_launch: hipFuncSetAttribute failed\n"); grid = -1; return; }
        if (hipOccupancyMaxActiveBlocksPerMultiprocessor(&per_cu, (const void*)fwd_kernel, NWAVES * 64, LDS_BYTES) != hipSuccess || per_cu < 1) { fprintf(stderr, "kernel_launch: occupancy query says %d blocks/CU\n", per_cu); (void)hipGetLastError(); grid = -1; return; }
        grid = cus;
    }
    if (grid < 0) return;
    if (hipMemsetAsync((char*)d_ws + WS_CTL, 0, CTL_ZERO_BYTES, stream) != hipSuccess) return;
    Args a{};
    for (int i = 0; i < 22; ++i) a.in[i] = (const float*)d_in[i];
    a.out = (float*)d_out; a.ws = (unsigned char*)d_ws;
    for (int li = 0; li < N_LAUNCHES; ++li) {
        a.ph_lo = (N_LAUNCHES == 1) ? 0 : li; a.ph_hi = (N_LAUNCHES == 1) ? N_PHASES : li + 1; a.li = li;
        hipLaunchKernelGGL(fwd_kernel, dim3(grid), dim3(NWAVES * 64), LDS_BYTES, stream, a);
    }
}
```

```cpp
#include <hip/hip_runtime.h>
#include <cstdio>
#include <cstdint>
#include <cmath>
namespace pg8 {
#define PG8_LAS __attribute__((address_space(3)))
typedef unsigned short bf16_t;
typedef short bf16x8 __attribute__((ext_vector_type(8)));
typedef float f32x4 __attribute__((ext_vector_type(4)));
typedef unsigned u32x4 __attribute__((ext_vector_type(4)));
constexpr int BM = 256, BK = 64, HALF = 128, HTB = HALF * BK * 2  , STAGE_BYTES = 8 * HTB, NXCD = 8, WGM = 8;

__host__ __device__ __forceinline__ int lds_byte(int r, int c) { const int st = (r >> 4) * 2 + (c >> 5), rr = r & 15, cc = c & 31, ob = rr * 64 + cc * 2; return st * 1024 + (ob ^ (((ob >> 9) & 1) << 5)); }
__host__ __device__ __forceinline__ void stage_rc(int b, int& R, int& C) { const int st = b / 1024, sb = b % 1024, swz = sb ^ (((sb >> 9) & 1) << 5); R = (st >> 1) * 16 + swz / 64; C = (st & 1) * 32 + (swz % 64) / 2; }
__host__ __device__ __forceinline__ int perm32(int rho) { const int n = rho >> 4, i = rho & 15; return 8 * (i >> 2) + 4 * n + (i & 3); }

struct Unit { int pm, pn; };
struct Gemm { const bf16_t* A; const bf16_t* Bt; int M, N, K; };

struct StaticOrder {
    int nM, nN, nwg, G, c;
    __host__ __device__ void init(int M, int N, int G_, int c_) { nM = M / BM; nN = N / BM; nwg = nM * nN; G = G_; c = c_; }
    __host__ __device__ bool next(int i, Unit& u) const {
        const long L = (long)i * G + c; if (L >= nwg) return false;
        int wgid = (int)L; { const int q = nwg / NXCD, r = nwg % NXCD, xcd = wgid % NXCD, off = wgid / NXCD; wgid = (xcd < r ? xcd * (q + 1) : r * (q + 1) + (xcd - r) * q) + off; }
        const int nig = WGM * nN, gid = wgid / nig, fm = gid * WGM, gsz = (nM - fm) < WGM ? (nM - fm) : WGM;
        u.pm = fm + ((wgid % nig) % gsz); u.pn = (wgid % nig) / gsz; return true;
    }
    __device__ __forceinline__ void a_ready(const Unit&) const {}
    __device__ __forceinline__ void done(const Unit&) const {}
};

__device__ __forceinline__ unsigned cvt_pk_bf16(float lo, float hi) { unsigned r; asm volatile("v_cvt_pk_bf16_f32 %0, %1, %2" : "=v"(r) : "v"(lo), "v"(hi)); return r; }
__device__ __forceinline__ float silu_f(float v) { return v * __builtin_amdgcn_rcpf(1.0f + __expf(-v)); }
constexpr int M_P = 16384, M_S = 128, M_TOT = M_P + M_S, MR = 16640;
constexpr int DM = 2048, NPROJ = 6144, DA = 1024;
constexpr float QSCALE = 0.125f * 1.4426950408889634f;
typedef float f32x2 __attribute__((ext_vector_type(2)));

struct EpiIn {
    static constexpr bool PERM = true, AFTER_DRAIN = false;
    bf16_t* H; float* kp; float* vp; float* ks; float* vs;
    __device__ __forceinline__ void operator()(const f32x4 (&acc)[2][2][4][2], const Unit& u, int wr, int wc, int fr, int fq) const {
        const int region = u.pn >> 2, colt = (u.pn & 3) * BM;
        bf16_t* base = H + (size_t)region * ((size_t)MR * DA);
        const int row0 = u.pm * BM + wr * 64 + fr, col0 = colt + wc * 32 + 8 * fq;
        float* fo_p = region == 1 ? kp : vp; float* fo_s = region == 1 ? ks : vs;
#pragma unroll
        for (int ai = 0; ai < 2; ++ai)
#pragma unroll
            for (int m = 0; m < 4; ++m) {
                const int row = row0 + ai * HALF + m * 16;
                bf16_t* rowp = base + (size_t)row * DA + col0;
                float* frow = nullptr;
                if (region == 1 || region == 2) {
                    if (row < M_P) { const int b = row >> 13, t = row & 8191; if (t >= 6144) frow = fo_p + ((size_t)(b * 2048 + (t - 6144))) * DA + col0; }
                    else if (row < M_TOT) frow = fo_s + (size_t)(row - M_P) * DA + col0;
                }
#pragma unroll
                for (int bj = 0; bj < 2; ++bj) {
                    f32x4 v0 = acc[ai][bj][m][0], v1 = acc[ai][bj][m][1];
                    if (region == 0) { v0 = v0 * QSCALE; v1 = v1 * QSCALE; }
                    if (region == 3 || region == 5) {
#pragma unroll
                        for (int e = 0; e < 4; ++e) { v0[e] = silu_f(v0[e]); v1[e] = silu_f(v1[e]); }
                    }
                    u32x4 w; w.x = cvt_pk_bf16(v0[0], v0[1]); w.y = cvt_pk_bf16(v0[2], v0[3]); w.z = cvt_pk_bf16(v1[0], v1[1]); w.w = cvt_pk_bf16(v1[2], v1[3]);
                    *(u32x4*)(rowp + bj * HALF) = w;
                    if (frow) { *(f32x4*)(frow + bj * HALF) = v0; *(f32x4*)(frow + bj * HALF + 4) = v1; }
                }
            }
    }
};
struct EpiGlu {
    static constexpr bool PERM = true, AFTER_DRAIN = false;
    const bf16_t* Z; const bf16_t* GS; const float* bias; bf16_t* BR;
    __device__ __forceinline__ void operator()(const f32x4 (&acc)[2][2][4][2], const Unit& u, int wr, int wc, int fr, int fq) const {
        const int row0 = u.pm * BM + wr * 64 + fr, col0 = u.pn * BM + wc * 32 + 8 * fq;
        f32x4 bv[2][2];
#pragma unroll
        for (int bj = 0; bj < 2; ++bj)
#pragma unroll
            for (int n = 0; n < 2; ++n) bv[bj][n] = *(const f32x4*)(bias + col0 + bj * HALF + 4 * n);
#pragma unroll
        for (int ai = 0; ai < 2; ++ai)
#pragma unroll
            for (int m = 0; m < 4; ++m) {
                const size_t row = (size_t)(row0 + ai * HALF + m * 16);
#pragma unroll
                for (int bj = 0; bj < 2; ++bj) {
                    const int col = col0 + bj * HALF;
                    const u32x4 zw = *(const u32x4*)(Z + row * 1024 + col), gw = *(const u32x4*)(GS + row * 1024 + col);
                    const f32x4 a0 = acc[ai][bj][m][0] + bv[bj][0], a1 = acc[ai][bj][m][1] + bv[bj][1];
                    float o[8];
#pragma unroll
                    for (int e = 0; e < 8; ++e) {
                        const unsigned zz = zw[e >> 1], gg = gw[e >> 1];
                        const float zf = __builtin_bit_cast(float, (e & 1) ? (zz & 0xffff0000u) : (zz << 16));
                        const float gf = __builtin_bit_cast(float, (e & 1) ? (gg & 0xffff0000u) : (gg << 16));
                        const float a = e < 4 ? a0[e & 3] : a1[e & 3];
                        o[e] = zf * __builtin_amdgcn_rcpf(1.0f + __expf(-a)) * gf;
                    }
                    u32x4 w; w.x = cvt_pk_bf16(o[0], o[1]); w.y = cvt_pk_bf16(o[2], o[3]); w.z = cvt_pk_bf16(o[4], o[5]); w.w = cvt_pk_bf16(o[6], o[7]);
                    *(u32x4*)(BR + row * 2048 + 1024 + col) = w;
                }
            }
    }
};
struct EpiOut {
    static constexpr bool PERM = false, AFTER_DRAIN = false;
    const float* xp; const float* xs; const float* bias; float* yp; float* ys; float alpha;
    __device__ __forceinline__ void operator()(const f32x4 (&acc)[2][2][4][2], const Unit& u, int wr, int wc, int fr, int fq) const {
        const int row0 = u.pm * BM + wr * 64 + fr, col0 = u.pn * BM + wc * 32 + 4 * fq;
        f32x4 bv[2][2];
#pragma unroll
        for (int bj = 0; bj < 2; ++bj)
#pragma unroll
            for (int n = 0; n < 2; ++n) bv[bj][n] = *(const f32x4*)(bias + col0 + bj * HALF + n * 16);
#pragma unroll
        for (int ai = 0; ai < 2; ++ai)
#pragma unroll
            for (int m = 0; m < 4; ++m) {
                const int row = row0 + ai * HALF + m * 16;
                if (row < M_TOT) {
                    const float* xr = row < M_P ? xp + (size_t)row * DM : xs + (size_t)(row - M_P) * DM;
                    float* yr = row < M_P ? yp + (size_t)row * DM : ys + (size_t)(row - M_P) * DM;
#pragma unroll
                    for (int bj = 0; bj < 2; ++bj)
#pragma unroll
                        for (int n = 0; n < 2; ++n) { const int col = col0 + bj * HALF + n * 16;
                            const f32x4 xv = *(const f32x4*)(xr + col);
                            *(f32x4*)(yr + col) = acc[ai][bj][m][n] + bv[bj][n] + xv * alpha; }
                }
            }
    }
};
template <class Epi, class Sched, bool ALIGN_EPI = false, bool SP2 = false>
__device__ __forceinline__ void gemm_phase(PG8_LAS unsigned char* lds, const Gemm g, const Sched& S, const Epi& E) {
    const int tid = threadIdx.x, wid = __builtin_amdgcn_readfirstlane(tid >> 6), lane = tid & 63, wr = wid >> 2, wc = wid & 3, fr = lane & 15, fq = lane >> 4;
    const int K = g.K, nt = K / BK;
    unsigned voffA[2], voffB[2];
#pragma unroll
    for (int i = 0; i < 2; ++i) { int R, C; stage_rc(tid * 16 + i * 8192, R, C); const int Rb = Epi::PERM ? ((R & ~31) + perm32(R & 31)) : R;
        voffA[i] = (unsigned)(R * K + C) * 2u; voffB[i] = (unsigned)(Rb * K + C) * 2u; }
    const size_t kstep = (size_t)(BK * 2);
    const size_t hstep = (size_t)HALF * K * 2;
    const size_t tstep = 2 * hstep;
    const unsigned ldsw = (unsigned)wid * 1024u;
    const int aoff = lds_byte(wr * 64 + fr, fq * 8), boff = lds_byte(wc * 32 + fr, fq * 8);
#define PG8_SA(b, h) (((b) * 2 + (h)) * HTB)
#define PG8_SB(b, h) ((4 + (b) * 2 + (h)) * HTB)
#define PG8_STAGE(bufoff, gbase, voff) do { _Pragma("unroll") for (int _i = 0; _i < 2; ++_i) \
        __builtin_amdgcn_global_load_lds((const unsigned*)((const char*)(gbase) + (voff)[_i]), (PG8_LAS unsigned*)(lds + (bufoff) + ldsw + _i * 8192), 16, 0, 0); } while (0)
#define PG8_LDA(dst, b, h) do { _Pragma("unroll") for (int m = 0; m < 4; ++m) _Pragma("unroll") for (int k = 0; k < 2; ++k) dst[m][k] = *(const PG8_LAS bf16x8*)(lds + PG8_SA(b, h) + aoff + m * 2048 + k * 1024); } while (0)
#define PG8_LDB(dst, b, h) do { _Pragma("unroll") for (int n = 0; n < 2; ++n) _Pragma("unroll") for (int k = 0; k < 2; ++k) dst[n][k] = *(const PG8_LAS bf16x8*)(lds + PG8_SB(b, h) + boff + n * 2048 + k * 1024); } while (0)
#define PG8_MMA(ai, bj, At, Bt) do { __builtin_amdgcn_s_setprio(1); _Pragma("unroll") for (int m = 0; m < 4; ++m) _Pragma("unroll") for (int n = 0; n < 2; ++n) _Pragma("unroll") for (int k = 0; k < 2; ++k) \
        acc[ai][bj][m][n] = __builtin_amdgcn_mfma_f32_16x16x32_bf16(Bt[n][k], At[m][k], acc[ai][bj][m][n], 0, 0, 0); __builtin_amdgcn_s_setprio(0); } while (0)
#define PG8_WAIT_V(n) asm volatile("s_waitcnt vmcnt(" #n ")" ::: "memory")
#define PG8_WAIT_L(n) asm volatile("s_waitcnt lgkmcnt(" #n ")" ::: "memory")
#define PG8_BAR __builtin_amdgcn_s_barrier()
#define PG8_SCHED __builtin_amdgcn_sched_barrier(0)
    Unit cur, nxt; int ui = 0;
    if (!S.next(0, cur)) return;
    f32x4 acc[2][2][4][2];
#pragma unroll
    for (int a = 0; a < 2; ++a)
#pragma unroll
        for (int b = 0; b < 2; ++b)
#pragma unroll
            for (int m = 0; m < 4; ++m)
#pragma unroll
                for (int n = 0; n < 2; ++n) acc[a][b][m][n] = (f32x4){0.f, 0.f, 0.f, 0.f};
    bf16x8 At[4][2], B0[2][2], B1[2][2];
    const char* cA = (const char*)g.A + (size_t)cur.pm * tstep; const char* cB = (const char*)g.Bt + (size_t)cur.pn * tstep;
    S.a_ready(cur);
    if constexpr (SP2) {
        PG8_STAGE(PG8_SB(0, 0), cB, voffB); PG8_STAGE(PG8_SB(0, 1), cB + hstep, voffB); PG8_STAGE(PG8_SA(0, 0), cA, voffA); PG8_STAGE(PG8_SA(0, 1), cA + hstep, voffA);
        if (wr == 1) PG8_BAR;
        PG8_WAIT_V(2); PG8_BAR;
        PG8_STAGE(PG8_SB(1, 0), cB + kstep, voffB); PG8_STAGE(PG8_SA(1, 0), cA + kstep, voffA); PG8_STAGE(PG8_SB(1, 1), cB + hstep + kstep, voffB);
        PG8_WAIT_V(6); PG8_BAR;
    } else {
        PG8_STAGE(PG8_SB(0, 0), cB, voffB); PG8_STAGE(PG8_SA(0, 0), cA, voffA); PG8_STAGE(PG8_SB(0, 1), cB + hstep, voffB); PG8_STAGE(PG8_SA(0, 1), cA + hstep, voffA);
        if (wr == 1) PG8_BAR;
        PG8_WAIT_V(4); PG8_BAR;
        PG8_STAGE(PG8_SB(1, 0), cB + kstep, voffB); PG8_STAGE(PG8_SA(1, 0), cA + kstep, voffA); PG8_STAGE(PG8_SB(1, 1), cB + hstep + kstep, voffB);
        PG8_WAIT_V(6); PG8_BAR;
    }
    for (;;) {
        const bool has_next = S.next(ui + 1, nxt);
        const char* nA = has_next ? (const char*)g.A + (size_t)nxt.pm * tstep : cA; const char* nB = has_next ? (const char*)g.Bt + (size_t)nxt.pn * tstep : cB;
        for (int t = 0; t < nt; t += 2) {
            const bool last = (t == nt - 2);
            const char* a1 = cA + (size_t)(t + 1) * kstep;
            const char* a2 = last ? nA : cA + (size_t)(t + 2) * kstep; const char* b2 = last ? nB : cB + (size_t)(t + 2) * kstep;
            const char* a3 = a2 + kstep; const char* b3 = b2 + kstep;
            if (last && has_next) S.a_ready(nxt);
            if constexpr (SP2) {
            PG8_LDB(B0, 0, 0); PG8_LDB(B1, 0, 1); PG8_SCHED; PG8_LDA(At, 0, 0); PG8_STAGE(PG8_SA(1, 1), a1 + hstep, voffA);
            PG8_WAIT_V(8); PG8_WAIT_L(0); PG8_BAR; PG8_MMA(0, 0, At, B0); PG8_MMA(0, 1, At, B1); PG8_BAR; PG8_SCHED;
            PG8_LDA(At, 0, 1); PG8_STAGE(PG8_SB(0, 0), b2, voffB); PG8_STAGE(PG8_SB(0, 1), b2 + hstep, voffB); PG8_STAGE(PG8_SA(0, 0), a2, voffA);
            PG8_WAIT_V(8); PG8_WAIT_L(0); PG8_BAR; PG8_MMA(1, 0, At, B0); PG8_MMA(1, 1, At, B1); PG8_BAR; PG8_SCHED;
            PG8_LDB(B0, 1, 0); PG8_LDB(B1, 1, 1); PG8_SCHED; PG8_LDA(At, 1, 0); PG8_STAGE(PG8_SA(0, 1), a2 + hstep, voffA);
            PG8_WAIT_V(8); PG8_WAIT_L(0); PG8_BAR; PG8_MMA(0, 0, At, B0); PG8_MMA(0, 1, At, B1); PG8_BAR; PG8_SCHED;
            PG8_LDA(At, 1, 1); PG8_STAGE(PG8_SB(1, 0), b3, voffB); PG8_STAGE(PG8_SB(1, 1), b3 + hstep, voffB); PG8_STAGE(PG8_SA(1, 0), a3, voffA);
            PG8_WAIT_V(8); PG8_WAIT_L(0); PG8_BAR; PG8_MMA(1, 0, At, B0); PG8_MMA(1, 1, At, B1); PG8_BAR; PG8_SCHED;
            } else {
            PG8_LDB(B0, 0, 0); PG8_SCHED; PG8_LDA(At, 0, 0); PG8_STAGE(PG8_SA(1, 1), a1 + hstep, voffA);
            PG8_WAIT_L(8); PG8_BAR; PG8_WAIT_L(0); PG8_MMA(0, 0, At, B0); PG8_BAR; PG8_SCHED;
            PG8_LDB(B1, 0, 1); PG8_STAGE(PG8_SB(0, 0), b2, voffB);
            PG8_BAR; PG8_WAIT_L(0); PG8_MMA(0, 1, At, B1); PG8_BAR;
            PG8_LDA(At, 0, 1); PG8_STAGE(PG8_SA(0, 0), a2, voffA);
            PG8_BAR; PG8_WAIT_L(0); PG8_MMA(1, 0, At, B0); PG8_BAR; PG8_SCHED;
            PG8_STAGE(PG8_SB(0, 1), b2 + hstep, voffB);
            PG8_WAIT_V(6); PG8_BAR; PG8_MMA(1, 1, At, B1); PG8_BAR;
            PG8_LDB(B0, 1, 0); PG8_SCHED; PG8_LDA(At, 1, 0); PG8_STAGE(PG8_SA(0, 1), a2 + hstep, voffA);
            PG8_WAIT_L(8); PG8_BAR; PG8_WAIT_L(0); PG8_MMA(0, 0, At, B0); PG8_BAR; PG8_SCHED;
            PG8_LDB(B1, 1, 1); PG8_STAGE(PG8_SB(1, 0), b3, voffB);
            PG8_BAR; PG8_WAIT_L(0); PG8_MMA(0, 1, At, B1); PG8_BAR;
            PG8_LDA(At, 1, 1); PG8_STAGE(PG8_SA(1, 0), a3, voffA);
            PG8_BAR; PG8_WAIT_L(0); PG8_MMA(1, 0, At, B0); PG8_BAR; PG8_SCHED;
            PG8_STAGE(PG8_SB(1, 1), b3 + hstep, voffB);
            PG8_WAIT_V(6); PG8_BAR; PG8_MMA(1, 1, At, B1); PG8_BAR;
            }
        }
        if constexpr (ALIGN_EPI) { if (wr == 0) PG8_BAR; }
        if constexpr (!Epi::AFTER_DRAIN) { E(acc, cur, wr, wc, fr, fq); S.done(cur); }
        if (!has_next) break;
#pragma unroll
        for (int a = 0; a < 2; ++a)
#pragma unroll
            for (int b = 0; b < 2; ++b)
#pragma unroll
                for (int m = 0; m < 4; ++m)
#pragma unroll
                    for (int n = 0; n < 2; ++n) acc[a][b][m][n] = (f32x4){0.f, 0.f, 0.f, 0.f};
        cur = nxt; cA = nA; cB = nB; ++ui;
        if constexpr (ALIGN_EPI) { if (wr == 1) PG8_BAR; }
    }
    PG8_WAIT_V(0);
    if constexpr (!ALIGN_EPI) { if (wr == 0) PG8_BAR; }
    PG8_BAR;
    if constexpr (Epi::AFTER_DRAIN) { E.fused(acc, cur, wr, wc, fr, fq, lds, wid, lane); S.done(cur); }
#undef PG8_SA
#undef PG8_SB
#undef PG8_STAGE
#undef PG8_LDA
#undef PG8_LDB
#undef PG8_MMA
#undef PG8_WAIT_V
#undef PG8_WAIT_L
#undef PG8_BAR
#undef PG8_SCHED
}
}
#define GAS __attribute__((address_space(1)))
#define LAS __attribute__((address_space(3)))
typedef unsigned short bf16;
typedef unsigned v4u __attribute__((ext_vector_type(4)));
typedef float f32x4 __attribute__((ext_vector_type(4)));
typedef short bf16x8 __attribute__((ext_vector_type(8)));
typedef GAS unsigned gu32;
typedef GAS unsigned long long gu64;
#define RLX_AGENT __ATOMIC_RELAXED, __HIP_MEMORY_SCOPE_AGENT
#define LDS_WAIT() asm volatile("s_waitcnt lgkmcnt(0)" ::: "memory")
#define VM_WAIT() asm volatile("s_waitcnt vmcnt(0)" ::: "memory")
__device__ __forceinline__ unsigned long long rt() { return __builtin_amdgcn_s_memrealtime(); }
__device__ __forceinline__ unsigned f2bf(float f) { unsigned u = __builtin_bit_cast(unsigned, f); return (u + 0x7fffu + ((u >> 16) & 1u)) >> 16; }
__device__ __forceinline__ unsigned pk2(float lo, float hi) { return f2bf(lo) | (f2bf(hi) << 16); }

#define XB_TMO      128
#define XB_XCNT(j)  (256  + 64 * (j))
#define XB_XSUB(j)  (1280 + 64 * (j))
#define XB_XGEN(j)  (2304 + 64 * (j))
#define XB_TOP      3328
#define XB_TOPGEN   3392
#define XCD_BAR_WORDS 3456
#define XB_SPIN_CAP (1u << 18)

__device__ __forceinline__ unsigned xb_ld(unsigned* p)              { return __hip_atomic_load(p, __ATOMIC_RELAXED, __HIP_MEMORY_SCOPE_AGENT); }
__device__ __forceinline__ unsigned xb_add(unsigned* p, unsigned v) { return __hip_atomic_fetch_add(p, v, __ATOMIC_RELAXED, __HIP_MEMORY_SCOPE_AGENT); }
__device__ __forceinline__ unsigned xb_xcc_id() { return (unsigned)__builtin_amdgcn_s_getreg((3 << 11) | 20) & 0xFu; }
#define XB_SPIN(cond, bar) do { unsigned _sp = 0; while (cond) { __builtin_amdgcn_s_sleep(1); \
    if ((++_sp & 255u) == 0u) { if (xb_ld(&(bar)[XB_TMO])) break; if (_sp > XB_SPIN_CAP) { atomicAdd(&(bar)[XB_TMO], 1u); break; } } } } while (0)

struct XcdBarrier {
    unsigned* bar; unsigned x;
    volatile LAS unsigned* st;
};

__device__ __forceinline__ XcdBarrier xcd_barrier_post(unsigned* bar, volatile LAS unsigned* st) {
    XcdBarrier b; b.bar = bar; b.x = xb_xcc_id(); b.st = st;
    if (threadIdx.x == 0) (void)xb_add(&bar[XB_XCNT(b.x)], 1u);
    return b;
}
__device__ __forceinline__ void xcd_barrier_complete(unsigned* bar, unsigned x, unsigned& nloc, unsigned& nx) {
    const unsigned G = gridDim.x * gridDim.y * gridDim.z;
    unsigned sum, cnt, mine, sp = 0u;
    for (;;) {
        sum = 0u; cnt = 0u; mine = 0u;
#pragma unroll
        for (unsigned j = 0; j < 16; ++j) { const unsigned c = xb_ld(&bar[XB_XCNT(j)]); sum += c; cnt += (c > 0u) ? 1u : 0u; mine = (j == x) ? c : mine; }
        if (sum == G) break;
        __builtin_amdgcn_s_sleep(1);
        if ((++sp & 255u) == 0u) { if (xb_ld(&bar[XB_TMO])) break; if (sp > XB_SPIN_CAP) { atomicAdd(&bar[XB_TMO], 1u); break; } }
    }
    nloc = mine > 0u ? mine : 1u; nx = cnt > 0u ? cnt : 1u;
}

__device__ __forceinline__ void xcd_barrier(const XcdBarrier& b) {
    asm volatile("s_waitcnt vmcnt(0)" ::: "memory");
    __syncthreads();
    if (threadIdx.x == 0) {
        unsigned* bar = b.bar;
        __builtin_amdgcn_s_waitcnt(0);
        unsigned nloc = b.st[0], nx = b.st[1];
        if (nloc == 0u) { xcd_barrier_complete(bar, b.x, nloc, nx); b.st[0] = nloc; b.st[1] = nx; }
        const unsigned old = xb_add(&bar[XB_XSUB(b.x)], 1u);
        const unsigned gen = old / nloc;
        if (old + 1u == (gen + 1u) * nloc) {
            __builtin_amdgcn_fence(__ATOMIC_RELEASE, "agent");
            asm volatile("s_waitcnt vmcnt(0)" ::: "memory");
            const unsigned og = xb_add(&bar[XB_TOP], 1u);
            const unsigned tg = og / nx;
            if (og + 1u == (tg + 1u) * nx) xb_add(&bar[XB_TOPGEN], 1u);
            else XB_SPIN(xb_ld(&bar[XB_TOPGEN]) == tg, bar);
            __builtin_amdgcn_fence(__ATOMIC_ACQUIRE, "agent");
            xb_add(&bar[XB_XGEN(b.x)], 1u);
            asm volatile("s_waitcnt vmcnt(0)" ::: "memory");
        } else {
            XB_SPIN(xb_ld(&bar[XB_XGEN(b.x)]) == gen, bar);
            __builtin_amdgcn_fence(__ATOMIC_ACQUIRE, "agent");
            asm volatile("s_waitcnt vmcnt(0)" ::: "memory");
        }
    }
    __syncthreads();
}
__device__ __forceinline__ float bf2f(unsigned short h) { return __builtin_bit_cast(float, (unsigned)h << 16); }
using pg8::M_P; using pg8::M_S; using pg8::M_TOT; using pg8::MR; using pg8::DM; using pg8::NPROJ; using pg8::DA;
constexpr int NWAVES = 8;
constexpr int SEQ = 8192, NHEAD = 16, HD = 64, NGRP = 64, NST = 64, NCH = 16;
constexpr float LN_EPS = 1e-5f;
constexpr float DN_ALPHA = 1.189207115002721f;
constexpr size_t MiB = 1u << 20;
constexpr size_t WS_CTL = 0, CTL_ZERO_BYTES = 1 * MiB;
constexpr size_t WS_WIN = 2 * MiB;
constexpr size_t WS_WGLU = 26 * MiB;
constexpr size_t WS_WOUT = 28 * MiB;
constexpr size_t WS_SA = 36 * MiB;
constexpr size_t WS_BBAR = 37 * MiB;
constexpr size_t WS_XB = 64 * MiB;
constexpr size_t WS_H = 136 * MiB;
constexpr size_t WS_BR = 336 * MiB;
constexpr size_t WS_Z = 404 * MiB;
constexpr size_t WS_END = 440 * MiB;
constexpr size_t HREG = (size_t)MR * DA;
constexpr size_t O_YP = 0, O_YS = 33554432, O_KP = 33816576, O_VP = 38010880, O_SRP = 42205184, O_SIP = 42213376,
                 O_KS = 42221568, O_VS = 42352640, O_SRS = 42483712, O_SIS = 42614784, O_TOTAL = 42745856;
constexpr int CW_TMO = 0, CW_CODE = 1, CW_BAR = 4096, CW_Q = 16384;
constexpr int RING_OFF = 0, RING_BYTES = 131072;
constexpr int LDSCTL_OFF = 143360, MISC_OFF = LDSCTL_OFF + 320;
constexpr int LDS_BYTES = 147456;
struct Frame {
    LAS unsigned char* lds;
    volatile LAS unsigned* MISC;
    gu32* ctl;
    int tid, lane, wave;
    int vcu, G;
    const float* in[22]; float* out; unsigned char* ws;
};
__device__ __forceinline__ float wave_sum(float v) {
#pragma unroll
    for (int o = 1; o < 64; o <<= 1) v += __shfl_xor(v, o);
    return v;
}
__device__ __forceinline__ void p0_transpose_item(const float* W, int K, int N, bf16* WT, LAS float* scr, int item, int lane) {
    const int nblk = N / 32, kb = item / nblk, nb = item % nblk, k0 = 64 * kb, n0 = 32 * nb;
#pragma unroll 8
    for (int i = 0; i < 32; ++i) { const int kk = 2 * i + (lane >> 5); scr[kk * 33 + (lane & 31)] = W[(size_t)(k0 + kk) * N + n0 + (lane & 31)]; }
    LDS_WAIT(); asm volatile("" ::: "memory");
    const int c = lane & 7;
#pragma unroll
    for (int j = 0; j < 4; ++j) { const int n = (lane >> 3) + 8 * j; const LAS float* s = scr + (8 * c) * 33 + n;
        v4u o; o.x = pk2(s[0 * 33], s[1 * 33]); o.y = pk2(s[2 * 33], s[3 * 33]); o.z = pk2(s[4 * 33], s[5 * 33]); o.w = pk2(s[6 * 33], s[7 * 33]);
        *(GAS v4u*)(WT + (size_t)(n0 + n) * K + k0 + 8 * c) = o; }
    LDS_WAIT(); asm volatile("" ::: "memory");
}
__device__ __forceinline__ void sincos_d(double x, double& s, double& c) {
    const double TWO_PI = 6.283185307179586476925286766559;
    const double k = rint(x / TWO_PI);
    const double r = fma(-k, TWO_PI, x);
    const double y = r * 0.125, y2 = y * y;
    double sn = y * (1.0 - y2 / 6.0 * (1.0 - y2 / 20.0 * (1.0 - y2 / 42.0 * (1.0 - y2 / 72.0 * (1.0 - y2 / 110.0 * (1.0 - y2 / 156.0 * (1.0 - y2 / 210.0)))))));
    double cs = 1.0 - y2 / 2.0 * (1.0 - y2 / 12.0 * (1.0 - y2 / 30.0 * (1.0 - y2 / 56.0 * (1.0 - y2 / 90.0 * (1.0 - y2 / 132.0 * (1.0 - y2 / 182.0 * (1.0 - y2 / 240.0)))))));
#pragma unroll
    for (int i = 0; i < 3; ++i) { const double s2 = 2.0 * sn * cs, c2 = cs * cs - sn * sn; sn = s2; cs = c2; }
    s = sn; c = cs;
}
__device__ __forceinline__ void p0_prologue(Frame& F) {
    LAS float* scr = (LAS float*)(F.lds + RING_OFF + F.wave * 16384);
    const int gw = F.vcu * NWAVES + F.wave, NGW = F.G * NWAVES;
    constexpr int I_IN = (DM / 64) * (NPROJ / 32), I_GLU = (1024 / 64) * (1024 / 32), I_OUT = (DM / 64) * (DM / 32);
    constexpr int NITEMS = I_IN + I_GLU + I_OUT;
    for (int it = gw; it < NITEMS; it += NGW) {
        int r = it;
        if (r < I_IN) { p0_transpose_item(F.in[6], DM, NPROJ, (bf16*)(F.ws + WS_WIN), scr, r, F.lane); continue; } r -= I_IN;
        if (r < I_GLU) { p0_transpose_item(F.in[18], 1024, 1024, (bf16*)(F.ws + WS_WGLU), scr, r, F.lane); continue; } r -= I_GLU;
        p0_transpose_item(F.in[7], DM, DM, (bf16*)(F.ws + WS_WOUT), scr, r, F.lane);
    }
    bf16* XB = (bf16*)(F.ws + WS_XB);
    for (int m = gw; m < MR; m += NGW) {
        GAS unsigned long long* o8 = (GAS unsigned long long*)(XB + (size_t)m * DM) + F.lane;
        if (m < M_TOT) {
            const float* xrow = m < M_P ? F.in[0] + (size_t)m * DM : F.in[1] + (size_t)(m - M_P) * DM;
            const GAS f32x4* xr = (const GAS f32x4*)xrow + F.lane;
#pragma unroll
            for (int j = 0; j < 8; ++j) { const f32x4 v = xr[64 * j]; o8[64 * j] = (unsigned long long)pk2(v.x, v.y) | ((unsigned long long)pk2(v.z, v.w) << 32); }
        } else {
#pragma unroll
            for (int j = 0; j < 8; ++j) o8[64 * j] = 0ull;
        }
    }
    const int gt = F.vcu * (NWAVES * 64) + F.tid;
    if (gt < NGRP * NST) {
        const int g = gt >> 6;
        const double lr = fmin((double)F.in[10][gt], -1e-4), li = (double)F.in[11][gt];
        const double dt = exp((double)F.in[12][g]);
        const double mag = exp(lr * dt); double sn, cs; sincos_d(li * dt, sn, cs);
        double ar = mag * cs, ai = mag * sn;
        const double den = lr * lr + li * li, inv_re = lr / den, inv_im = -li / den;
        const double n_re = ar - 1.0, n_im = ai;
        const double cf_re = n_re * inv_re - n_im * inv_im, cf_im = n_re * inv_im + n_im * inv_re;
        float* SA = (float*)(F.ws + WS_SA) + (size_t)gt * 8;
        SA[0] = (float)ar; SA[1] = (float)ai;
        double pr = ar, pi = ai;
        for (int i = 0; i < 10; ++i) { const double t = pr * pr - pi * pi; pi = 2.0 * pr * pi; pr = t; if (i == 4) { SA[2] = (float)pr; SA[3] = (float)pi; } }
        SA[4] = (float)pr; SA[5] = (float)pi; SA[6] = 0.f; SA[7] = 0.f;
        float* BB = (float*)(F.ws + WS_BBAR) + (size_t)gt * 32;
        const float* br = F.in[13] + (size_t)gt * 16; const float* bi = F.in[14] + (size_t)gt * 16;
        for (int c = 0; c < 16; ++c) { const double x = br[c], y = bi[c]; BB[2 * c] = (float)(cf_re * x - cf_im * y); BB[2 * c + 1] = (float)(cf_re * y + cf_im * x); }
    }
}
__device__ __forceinline__ int t5_bucket(int dist) {
    if (dist < 16) return dist;
    const float v = logf((float)dist / 16.0f) / 4.852030263919617f * 16.0f;
    const int large = 16 + (int)v;
    return large < 31 ? large : 31;
}
__device__ __forceinline__ float gelu_tanh(float y) {
    const float a = 0.7978845608028654f * (y + 0.044715f * y * y * y);
    const float t = __expf(2.0f * a);
    return 0.5f * y * (2.0f - 2.0f * __builtin_amdgcn_rcpf(t + 1.0f));
}
template <bool SAMPLE>
__device__ __forceinline__ void attn_simple_task(Frame& F, int task, const LAS int* bkt) {
    const int h = task & 15, rowi = task >> 4;
    const bf16* Hq = (const bf16*)(F.ws + WS_H);
    const size_t qrow = SAMPLE ? (size_t)(M_P + rowi) : (size_t)rowi;
    const int b = SAMPLE ? (rowi >> 2) : (rowi >> 13), t = SAMPLE ? (2048 + (rowi & 3)) : (rowi & 8191);
    unsigned qp[32];
    { const v4u* qv = (const v4u*)(Hq + qrow * DA + h * HD);
#pragma unroll
      for (int i = 0; i < 8; ++i) { const v4u w = qv[i]; qp[4 * i] = w.x; qp[4 * i + 1] = w.y; qp[4 * i + 2] = w.z; qp[4 * i + 3] = w.w; } }
    const bf16* Kb = Hq + HREG; const bf16* Vb = Hq + 2 * HREG;
    const float* ck = F.in[2]; const float* cv = F.in[3]; const float* kn = F.out + O_KS; const float* vn = F.out + O_VS;
    LAS float* lgs = (LAS float*)(F.lds + RING_OFF + 4096 + F.wave * 2048);
    float mx = -INFINITY;
#pragma unroll 1
    for (int i = 0; i < 7; ++i) {
        const int e = F.lane + 64 * i; float v = -INFINITY;
        if (e < 387) {
            const int p = e / 129, j = e - p * 129, d = p == 0 ? 1 : (p == 1 ? 4 : 16), kt = t - j * d;
            if (kt >= 0) {
                float dot = 0.f;
                if (SAMPLE) {
                    const float* kr = kt < 2048 ? ck + (((size_t)b * 2048 + kt) * NHEAD + h) * HD : kn + ((size_t)(b * 4 + kt - 2048)) * DA + h * HD;
#pragma unroll
                    for (int c = 0; c < 16; ++c) { const f32x4 kv = *(const f32x4*)(kr + 4 * c); const unsigned q0 = qp[2 * c], q1 = qp[2 * c + 1];
                        dot += __builtin_bit_cast(float, q0 << 16) * kv.x + __builtin_bit_cast(float, q0 & 0xffff0000u) * kv.y + __builtin_bit_cast(float, q1 << 16) * kv.z + __builtin_bit_cast(float, q1 & 0xffff0000u) * kv.w; }
                } else {
                    const v4u* kr = (const v4u*)(Kb + ((size_t)b * SEQ + kt) * DA + h * HD);
#pragma unroll
                    for (int c = 0; c < 8; ++c) { const v4u kw = kr[c];
#pragma unroll
                        for (int x = 0; x < 4; ++x) { const unsigned kk = kw[x], qq = qp[4 * c + x];
                            dot += __builtin_bit_cast(float, qq << 16) * __builtin_bit_cast(float, kk << 16) + __builtin_bit_cast(float, qq & 0xffff0000u) * __builtin_bit_cast(float, kk & 0xffff0000u); } }
                }
                v = dot + F.in[9][bkt[e] * NHEAD + h] * 1.4426950408889634f;
            }
            lgs[e] = v;
        }
        mx = fmaxf(mx, v);
    }
#pragma unroll
    for (int o = 1; o < 64; o <<= 1) mx = fmaxf(mx, __shfl_xor(mx, o));
    float sum = 0.f;
#pragma unroll 1
    for (int i = 0; i < 7; ++i) { const int e = F.lane + 64 * i; if (e < 387) { const float pr = exp2f(lgs[e] - mx); lgs[e] = pr; sum += pr; } }
    sum = wave_sum(sum);
    LDS_WAIT(); asm volatile("" ::: "memory");
    float acc = 0.f;
#pragma unroll 1
    for (int p = 0; p < 3; ++p) {
        const int d = p == 0 ? 1 : (p == 1 ? 4 : 16);
#pragma unroll 4
        for (int j = 0; j < 129; ++j) {
            const int kt = t - j * d;
            if (kt < 0) break;
            const float pe = lgs[p * 129 + j];
            float vv;
            if (SAMPLE) vv = kt < 2048 ? cv[(((size_t)b * 2048 + kt) * NHEAD + h) * HD + F.lane] : vn[((size_t)(b * 4 + kt - 2048)) * DA + h * HD + F.lane];
            else vv = bf2f(Vb[((size_t)b * SEQ + kt) * DA + h * HD + F.lane]);
            acc += pe * vv;
        }
    }
    LDS_WAIT(); asm volatile("" ::: "memory");
    const float ga = bf2f(Hq[3 * HREG + qrow * DA + h * HD + F.lane]);
    ((bf16*)(F.ws + WS_BR))[qrow * 2048 + h * HD + F.lane] = (bf16)f2bf(acc / sum * ga);
}
__device__ __forceinline__ void ssm_seq(Frame& F, int g, size_t rowbase, int L, const float* x0r, const float* x0i, float* outr, float* outi) {
    const int n = F.lane;
    const float* SA = (const float*)(F.ws + WS_SA) + (size_t)(g * NST + n) * 8;
    const float ar = SA[0], ai = SA[1];
    const float* BB = (const float*)(F.ws + WS_BBAR) + (size_t)(g * NST + n) * 32;
    float bbr[16], bbi[16], cre[16], cim[16];
#pragma unroll
    for (int c = 0; c < 16; ++c) { bbr[c] = BB[2 * c]; bbi[c] = BB[2 * c + 1]; cre[c] = F.in[15][(size_t)(g * NCH + c) * NST + n]; cim[c] = F.in[16][(size_t)(g * NCH + c) * NST + n]; }
    const float dsk = F.in[17][g * NCH + (n & 15)];
    float xr = x0r ? x0r[n] : 0.f, xi = x0i ? x0i[n] : 0.f;
    const bf16* U = (const bf16*)(F.ws + WS_H) + 4 * HREG; bf16* Z = (bf16*)(F.ws + WS_Z);
    for (int t = 0; t < L; ++t) {
        const size_t row = rowbase + t;
        const v4u* up = (const v4u*)(U + row * DA + g * NCH);
        const v4u u0 = up[0], u1 = up[1];
        float u[16];
#pragma unroll
        for (int c = 0; c < 4; ++c) { u[2 * c] = __builtin_bit_cast(float, u0[c] << 16); u[2 * c + 1] = __builtin_bit_cast(float, u0[c] & 0xffff0000u); u[8 + 2 * c] = __builtin_bit_cast(float, u1[c] << 16); u[9 + 2 * c] = __builtin_bit_cast(float, u1[c] & 0xffff0000u); }
        float bur = 0.f, bui = 0.f;
#pragma unroll
        for (int c = 0; c < 16; ++c) { bur += bbr[c] * u[c]; bui += bbi[c] * u[c]; }
        const float nxr = ar * xr - ai * xi + bur, nxi = ar * xi + ai * xr + bui;
        xr = nxr; xi = nxi;
        float yv = 0.f, uv = 0.f;
#pragma unroll
        for (int c = 0; c < 16; ++c) { const float s = wave_sum(cre[c] * xr - cim[c] * xi); if ((n & 15) == c) { yv = s; uv = u[c]; } }
        yv += dsk * uv;
        if (n < 16) Z[row * DA + g * NCH + n] = (bf16)f2bf(gelu_tanh(yv));
    }
    outr[n] = xr; outi[n] = xi;
}
__device__ __forceinline__ void ln_row_inplace(Frame& F, float* row) {
    GAS f32x4* xr = (GAS f32x4*)row + F.lane;
    f32x4 v[8]; float s = 0.f;
#pragma unroll
    for (int j = 0; j < 8; ++j) { v[j] = xr[64 * j]; s += (v[j].x + v[j].y) + (v[j].z + v[j].w); }
    const float mean = wave_sum(s) * (1.f / DM); float s2 = 0.f;
#pragma unroll
    for (int j = 0; j < 8; ++j) { v[j] = v[j] - mean; s2 += (v[j].x * v[j].x + v[j].y * v[j].y) + (v[j].z * v[j].z + v[j].w * v[j].w); }
    const float rstd = 1.f / sqrtf(wave_sum(s2) * (1.f / DM) + LN_EPS);
    const GAS f32x4* gp = (const GAS f32x4*)F.in[20] + F.lane; const GAS f32x4* bp = (const GAS f32x4*)F.in[21] + F.lane;
#pragma unroll
    for (int j = 0; j < 8; ++j) xr[64 * j] = v[j] * rstd * gp[64 * j] + bp[64 * j];
}
#ifndef MK_N_LAUNCHES
#define MK_N_LAUNCHES 1
#endif
constexpr int N_PHASES = 6;
constexpr int N_LAUNCHES = MK_N_LAUNCHES;
struct Args { const float* in[22]; float* out; unsigned char* ws; int ph_lo, ph_hi, li, pad; };
__global__ void __launch_bounds__(NWAVES * 64, 2) fwd_kernel(Args args) {
    extern __shared__ __attribute__((aligned(16))) unsigned char lds[];
    Frame F;
    F.lds = (LAS unsigned char*)lds;
    F.MISC = (volatile LAS unsigned*)(F.lds + MISC_OFF);
    F.tid = threadIdx.x; F.lane = F.tid & 63; F.wave = __builtin_amdgcn_readfirstlane(F.tid >> 6);
    F.G = gridDim.x; { const int bx = blockIdx.x; F.vcu = (F.G % 8 == 0) ? (bx % 8) * (F.G / 8) + bx / 8 : bx; }
    F.ws = args.ws; F.out = args.out;
#pragma unroll
    for (int i = 0; i < 22; ++i) F.in[i] = args.in[i];
    F.ctl = (gu32*)(F.ws + WS_CTL);
    for (int u = F.tid; u < (LDS_BYTES - LDSCTL_OFF) / 4; u += NWAVES * 64) ((LAS unsigned*)(F.lds + LDSCTL_OFF))[u] = 0u;
    __syncthreads();
    XcdBarrier bar; bar.bar = (unsigned*)(F.ctl + CW_BAR); bar.x = 0; bar.st = nullptr;
    if (N_LAUNCHES == 1) bar = xcd_barrier_post((unsigned*)(F.ctl + CW_BAR), F.MISC + 8);
    const int lo = args.ph_lo, hi = args.ph_hi;
#define IN(k) (lo <= (k) && (k) < hi)
#define BOTH(k) (IN(k) && IN((k) + 1))
#define GRID_BAR() do { if (N_LAUNCHES == 1) xcd_barrier(bar); } while (0)

    if (IN(0)) { p0_prologue(F); if (BOTH(0)) GRID_BAR(); }
    if (IN(1)) {
        pg8::Gemm g{(const pg8::bf16_t*)(F.ws + WS_XB), (const pg8::bf16_t*)(F.ws + WS_WIN), MR, NPROJ, DM};
        pg8::StaticOrder S; S.init(MR, NPROJ, F.G, (int)blockIdx.x);
        pg8::EpiIn E{(pg8::bf16_t*)(F.ws + WS_H), F.out + O_KP, F.out + O_VP, F.out + O_KS, F.out + O_VS};
        pg8::gemm_phase<pg8::EpiIn, pg8::StaticOrder, true, true>(F.lds + RING_OFF, g, S, E);
        if (BOTH(1)) GRID_BAR();
    }

    if (IN(2)) {
        LAS int* bkt = (LAS int*)(F.lds + RING_OFF);
        for (int e = F.tid; e < 387; e += NWAVES * 64) { const int p = e / 129, j = e - p * 129, d = p == 0 ? 1 : (p == 1 ? 4 : 16); bkt[e] = t5_bucket(j * d); }
        __syncthreads();
        const int gw = F.vcu * NWAVES + F.wave, NGW = F.G * NWAVES;
        if (F.wave == 0 && F.vcu < 2 * NGRP) { const int b = F.vcu >> 6, g = F.vcu & 63;
            ssm_seq(F, g, (size_t)b * SEQ, SEQ, nullptr, nullptr, F.out + O_SRP + (size_t)(b * NGRP + g) * NST, F.out + O_SIP + (size_t)(b * NGRP + g) * NST); }
        for (int task = gw; task < 32 * NGRP; task += NGW) { const int db = task >> 6, g = task & 63;
            ssm_seq(F, g, (size_t)M_P + db * 4, 4, F.in[4] + (size_t)task * NST, F.in[5] + (size_t)task * NST, F.out + O_SRS + (size_t)task * NST, F.out + O_SIS + (size_t)task * NST); }
        for (int task = gw; task < M_S * NHEAD; task += NGW) attn_simple_task<true>(F, task, bkt);
        for (int task = gw; task < M_P * NHEAD; task += NGW) attn_simple_task<false>(F, task, bkt);
        if (BOTH(2)) GRID_BAR();
    }
    if (IN(3)) {
        pg8::Gemm g{(const pg8::bf16_t*)(F.ws + WS_Z), (const pg8::bf16_t*)(F.ws + WS_WGLU), MR, 1024, 1024};
        pg8::StaticOrder S; S.init(MR, 1024, F.G, (int)blockIdx.x);
        pg8::EpiGlu E{(const pg8::bf16_t*)(F.ws + WS_Z), (const pg8::bf16_t*)(F.ws + WS_H) + 5 * HREG, F.in[19], (pg8::bf16_t*)(F.ws + WS_BR)};
        pg8::gemm_phase<pg8::EpiGlu, pg8::StaticOrder, true, true>(F.lds + RING_OFF, g, S, E);
        if (BOTH(3)) GRID_BAR();
    }
    if (IN(4)) {
        pg8::Gemm g{(const pg8::bf16_t*)(F.ws + WS_BR), (const pg8::bf16_t*)(F.ws + WS_WOUT), MR, DM, DM};
        pg8::StaticOrder S; S.init(MR, DM, F.G, (int)blockIdx.x);
        pg8::EpiOut E{F.in[0], F.in[1], F.in[8], F.out + O_YP, F.out + O_YS, DN_ALPHA};
        pg8::gemm_phase<pg8::EpiOut, pg8::StaticOrder, true, true>(F.lds + RING_OFF, g, S, E);
        if (BOTH(4)) GRID_BAR();
    }
    if (IN(5)) {
        const int gw = F.vcu * NWAVES + F.wave, NGW = F.G * NWAVES;
        for (int m = gw; m < M_TOT; m += NGW) ln_row_inplace(F, m < M_P ? F.out + O_YP + (size_t)m * DM : F.out + O_YS + (size_t)(m - M_P) * DM);
    }
#undef IN
#undef BOTH
}

extern "C" void kernel_launch(void* const* d_in, const int* in_sizes, int n_in, void* d_out, int out_size, void* d_ws, size_t ws_size, hipStream_t stream) {
    static int grid = 0;
    if (grid == 0) {
        if (n_in != 22 || (size_t)out_size != O_TOTAL || ws_size < WS_END) { fprintf(stderr, "kernel_launch: unexpected shapes: n_in %d out %d ws %zu\n", n_in, out_size, ws_size); grid = -1; return; }
        int dev = 0, cus = 0, per_cu = 0;
        if (hipGetDevice(&dev) != hipSuccess || hipDeviceGetAttribute(&cus, hipDeviceAttributeMultiprocessorCount, dev) != hipSuccess) { grid = -1; return; }
        if (hipFuncSetAttribute((const void*)fwd_kernel, hipFuncAttributeMaxDynamicSharedMemorySize, LDS_BYTES) != hipSuccess) { fprintf(stderr, "kernel_launch: hipFuncSetAttribute failed\n"); grid = -1; return; }
        if (hipOccupancyMaxActiveBlocksPerMultiprocessor(&per_cu, (const void*)fwd_kernel, NWAVES * 64, LDS_BYTES) != hipSuccess || per_cu < 1) { fprintf(stderr, "kernel_launch: occupancy query says %d blocks/CU\n", per_cu); (void)hipGetLastError(); grid = -1; return; }
        grid = cus;
    }
    if (grid < 0) return;
    if (hipMemsetAsync((char*)d_ws + WS_CTL, 0, CTL_ZERO_BYTES, stream) != hipSuccess) return;
    Args a{};
    for (int i = 0; i < 22; ++i) a.in[i] = (const float*)d_in[i];
    a.out = (float*)d_out; a.ws = (unsigned char*)d_ws;
    for (int li = 0; li < N_LAUNCHES; ++li) {
        a.ph_lo = (N_LAUNCHES == 1) ? 0 : li; a.ph_hi = (N_LAUNCHES == 1) ? N_PHASES : li + 1; a.li = li;
        hipLaunchKernelGGL(fwd_kernel, dim3(grid), dim3(NWAVES * 64), LDS_BYTES, stream, a);
    }
}
```

```cpp
#include <hip/hip_runtime.h>
#include <cstdio>
#include <cstdint>
#include <cmath>
namespace pg8 {
#define PG8_LAS __attribute__((address_space(3)))
typedef unsigned short bf16_t;
typedef short bf16x8 __attribute__((ext_vector_type(8)));
typedef float f32x4 __attribute__((ext_vector_type(4)));
typedef unsigned u32x4 __attribute__((ext_vector_type(4)));
constexpr int BM = 256, BK = 64, HALF = 128, HTB = HALF * BK * 2  , STAGE_BYTES = 8 * HTB, NXCD = 8, WGM = 8;

__host__ __device__ __forceinline__ int lds_byte(int r, int c) { const int st = (r >> 4) * 2 + (c >> 5), rr = r & 15, cc = c & 31, ob = rr * 64 + cc * 2; return st * 1024 + (ob ^ (((ob >> 9) & 1) << 5)); }
__host__ __device__ __forceinline__ void stage_rc(int b, int& R, int& C) { const int st = b / 1024, sb = b % 1024, swz = sb ^ (((sb >> 9) & 1) << 5); R = (st >> 1) * 16 + swz / 64; C = (st & 1) * 32 + (swz % 64) / 2; }
__host__ __device__ __forceinline__ int perm32(int rho) { const int n = rho >> 4, i = rho & 15; return 8 * (i >> 2) + 4 * n + (i & 3); }

struct Unit { int pm, pn; };
struct Gemm { const bf16_t* A; const bf16_t* Bt; int M, N, K; };

struct StaticOrder {
    int nM, nN, nwg, G, c;
    __host__ __device__ void init(int M, int N, int G_, int c_) { nM = M / BM; nN = N / BM; nwg = nM * nN; G = G_; c = c_; }
    __host__ __device__ bool next(int i, Unit& u) const {
        const long L = (long)i * G + c; if (L >= nwg) return false;
        int wgid = (int)L; { const int q = nwg / NXCD, r = nwg % NXCD, xcd = wgid % NXCD, off = wgid / NXCD; wgid = (xcd < r ? xcd * (q + 1) : r * (q + 1) + (xcd - r) * q) + off; }
        const int nig = WGM * nN, gid = wgid / nig, fm = gid * WGM, gsz = (nM - fm) < WGM ? (nM - fm) : WGM;
        u.pm = fm + ((wgid % nig) % gsz); u.pn = (wgid % nig) / gsz; return true;
    }
    __device__ __forceinline__ void a_ready(const Unit&) const {}
    __device__ __forceinline__ void done(const Unit&) const {}
};

__device__ __forceinline__ unsigned cvt_pk_bf16(float lo, float hi) { unsigned r; asm volatile("v_cvt_pk_bf16_f32 %0, %1, %2" : "=v"(r) : "v"(lo), "v"(hi)); return r; }
__device__ __forceinline__ float silu_f(float v) { return v * __builtin_amdgcn_rcpf(1.0f + __expf(-v)); }
constexpr int M_P = 16384, M_S = 128, M_TOT = M_P + M_S, MR = 16640;
constexpr int DM = 2048, NPROJ = 6144, DA = 1024;
constexpr float QSCALE = 0.125f * 1.4426950408889634f;
typedef float f32x2 __attribute__((ext_vector_type(2)));

struct EpiIn {
    static constexpr bool PERM = true, AFTER_DRAIN = false;
    bf16_t* H; float* kp; float* vp; float* ks; float* vs;
    __device__ __forceinline__ void operator()(const f32x4 (&acc)[2][2][4][2], const Unit& u, int wr, int wc, int fr, int fq) const {
        const int region = u.pn >> 2, colt = (u.pn & 3) * BM;
        bf16_t* base = H + (size_t)region * ((size_t)MR * DA);
        const int row0 = u.pm * BM + wr * 64 + fr, col0 = colt + wc * 32 + 8 * fq;
        float* fo_p = region == 1 ? kp : vp; float* fo_s = region == 1 ? ks : vs;
#pragma unroll
        for (int ai = 0; ai < 2; ++ai)
#pragma unroll
            for (int m = 0; m < 4; ++m) {
                const int row = row0 + ai * HALF + m * 16;
                bf16_t* rowp = base + (size_t)row * DA + col0;
                float* frow = nullptr;
                if (region == 1 || region == 2) {
                    if (row < M_P) { const int b = row >> 13, t = row & 8191; if (t >= 6144) frow = fo_p + ((size_t)(b * 2048 + (t - 6144))) * DA + col0; }
                    else if (row < M_TOT) frow = fo_s + (size_t)(row - M_P) * DA + col0;
                }
#pragma unroll
                for (int bj = 0; bj < 2; ++bj) {
                    f32x4 v0 = acc[ai][bj][m][0], v1 = acc[ai][bj][m][1];
                    if (region == 0) { v0 = v0 * QSCALE; v1 = v1 * QSCALE; }
                    if (region == 3 || region == 5) {
#pragma unroll
                        for (int e = 0; e < 4; ++e) { v0[e] = silu_f(v0[e]); v1[e] = silu_f(v1[e]); }
                    }
                    u32x4 w; w.x = cvt_pk_bf16(v0[0], v0[1]); w.y = cvt_pk_bf16(v0[2], v0[3]); w.z = cvt_pk_bf16(v1[0], v1[1]); w.w = cvt_pk_bf16(v1[2], v1[3]);
                    *(u32x4*)(rowp + bj * HALF) = w;
                    if (frow) { *(f32x4*)(frow + bj * HALF) = v0; *(f32x4*)(frow + bj * HALF + 4) = v1; }
                }
            }
    }
};
struct EpiGlu {
    static constexpr bool PERM = true, AFTER_DRAIN = false;
    const bf16_t* Z; const bf16_t* GS; const float* bias; bf16_t* BR;
    __device__ __forceinline__ void operator()(const f32x4 (&acc)[2][2][4][2], const Unit& u, int wr, int wc, int fr, int fq) const {
        const int row0 = u.pm * BM + wr * 64 + fr, col0 = u.pn * BM + wc * 32 + 8 * fq;
        f32x4 bv[2][2];
#pragma unroll
        for (int bj = 0; bj < 2; ++bj)
#pragma unroll
            for (int n = 0; n < 2; ++n) bv[bj][n] = *(const f32x4*)(bias + col0 + bj * HALF + 4 * n);
#pragma unroll
        for (int ai = 0; ai < 2; ++ai)
#pragma unroll
            for (int m = 0; m < 4; ++m) {
                const size_t row = (size_t)(row0 + ai * HALF + m * 16);
#pragma unroll
                for (int bj = 0; bj < 2; ++bj) {
                    const int col = col0 + bj * HALF;
                    const u32x4 zw = *(const u32x4*)(Z + row * 1024 + col), gw = *(const u32x4*)(GS + row * 1024 + col);
                    const f32x4 a0 = acc[ai][bj][m][0] + bv[bj][0], a1 = acc[ai][bj][m][1] + bv[bj][1];
                    float o[8];
#pragma unroll
                    for (int e = 0; e < 8; ++e) {
                        const unsigned zz = zw[e >> 1], gg = gw[e >> 1];
                        const float zf = __builtin_bit_cast(float, (e & 1) ? (zz & 0xffff0000u) : (zz << 16));
                        const float gf = __builtin_bit_cast(float, (e & 1) ? (gg & 0xffff0000u) : (gg << 16));
                        const float a = e < 4 ? a0[e & 3] : a1[e & 3];
                        o[e] = zf * __builtin_amdgcn_rcpf(1.0f + __expf(-a)) * gf;
                    }
                    u32x4 w; w.x = cvt_pk_bf16(o[0], o[1]); w.y = cvt_pk_bf16(o[2], o[3]); w.z = cvt_pk_bf16(o[4], o[5]); w.w = cvt_pk_bf16(o[6], o[7]);
                    *(u32x4*)(BR + row * 2048 + 1024 + col) = w;
                }
            }
    }
};
struct EpiOut {
    static constexpr bool PERM = false, AFTER_DRAIN = false;
    const float* xp; const float* xs; const float* bias; float* yp; float* ys; float alpha;
    __device__ __forceinline__ void operator()(const f32x4 (&acc)[2][2][4][2], const Unit& u, int wr, int wc, int fr, int fq) const {
        const int row0 = u.pm * BM + wr * 64 + fr, col0 = u.pn * BM + wc * 32 + 4 * fq;
        f32x4 bv[2][2];
#pragma unroll
        for (int bj = 0; bj < 2; ++bj)
#pragma unroll
            for (int n = 0; n < 2; ++n) bv[bj][n] = *(const f32x4*)(bias + col0 + bj * HALF + n * 16);
#pragma unroll
        for (int ai = 0; ai < 2; ++ai)
#pragma unroll
            for (int m = 0; m < 4; ++m) {
                const int row = row0 + ai * HALF + m * 16;
                if (row < M_TOT) {
                    const float* xr = row < M_P ? xp + (size_t)row * DM : xs + (size_t)(row - M_P) * DM;
                    float* yr = row < M_P ? yp + (size_t)row * DM : ys + (size_t)(row - M_P) * DM;
#pragma unroll
                    for (int bj = 0; bj < 2; ++bj)
#pragma unroll
                        for (int n = 0; n < 2; ++n) { const int col = col0 + bj * HALF + n * 16;
                            const f32x4 xv = *(const f32x4*)(xr + col);
                            *(f32x4*)(yr + col) = acc[ai][bj][m][n] + bv[bj][n] + xv * alpha; }
                }
            }
    }
};
template <class Epi, class Sched, bool ALIGN_EPI = false, bool SP2 = false>
__device__ __forceinline__ void gemm_phase(PG8_LAS unsigned char* lds, const Gemm g, const Sched& S, const Epi& E) {
    const int tid = threadIdx.x, wid = __builtin_amdgcn_readfirstlane(tid >> 6), lane = tid & 63, wr = wid >> 2, wc = wid & 3, fr = lane & 15, fq = lane >> 4;
    const int K = g.K, nt = K / BK;
    unsigned voffA[2], voffB[2];
#pragma unroll
    for (int i = 0; i < 2; ++i) { int R, C; stage_rc(tid * 16 + i * 8192, R, C); const int Rb = Epi::PERM ? ((R & ~31) + perm32(R & 31)) : R;
        voffA[i] = (unsigned)(R * K + C) * 2u; voffB[i] = (unsigned)(Rb * K + C) * 2u; }
    const size_t kstep = (size_t)(BK * 2);
    const size_t hstep = (size_t)HALF * K * 2;
    const size_t tstep = 2 * hstep;
    const unsigned ldsw = (unsigned)wid * 1024u;
    const int aoff = lds_byte(wr * 64 + fr, fq * 8), boff = lds_byte(wc * 32 + fr, fq * 8);
#define PG8_SA(b, h) (((b) * 2 + (h)) * HTB)
#define PG8_SB(b, h) ((4 + (b) * 2 + (h)) * HTB)
#define PG8_STAGE(bufoff, gbase, voff) do { _Pragma("unroll") for (int _i = 0; _i < 2; ++_i) \
        __builtin_amdgcn_global_load_lds((const unsigned*)((const char*)(gbase) + (voff)[_i]), (PG8_LAS unsigned*)(lds + (bufoff) + ldsw + _i * 8192), 16, 0, 0); } while (0)
#define PG8_LDA(dst, b, h) do { _Pragma("unroll") for (int m = 0; m < 4; ++m) _Pragma("unroll") for (int k = 0; k < 2; ++k) dst[m][k] = *(const PG8_LAS bf16x8*)(lds + PG8_SA(b, h) + aoff + m * 2048 + k * 1024); } while (0)
#define PG8_LDB(dst, b, h) do { _Pragma("unroll") for (int n = 0; n < 2; ++n) _Pragma("unroll") for (int k = 0; k < 2; ++k) dst[n][k] = *(const PG8_LAS bf16x8*)(lds + PG8_SB(b, h) + boff + n * 2048 + k * 1024); } while (0)
#define PG8_MMA(ai, bj, At, Bt) do { __builtin_amdgcn_s_setprio(1); _Pragma("unroll") for (int m = 0; m < 4; ++m) _Pragma("unroll") for (int n = 0; n < 2; ++n) _Pragma("unroll") for (int k = 0; k < 2; ++k) \
        acc[ai][bj][m][n] = __builtin_amdgcn_mfma_f32_16x16x32_bf16(Bt[n][k], At[m][k], acc[ai][bj][m][n], 0, 0, 0); __builtin_amdgcn_s_setprio(0); } while (0)
#define PG8_WAIT_V(n) asm volatile("s_waitcnt vmcnt(" #n ")" ::: "memory")
#define PG8_WAIT_L(n) asm volatile("s_waitcnt lgkmcnt(" #n ")" ::: "memory")
#define PG8_BAR __builtin_amdgcn_s_barrier()
#define PG8_SCHED __builtin_amdgcn_sched_barrier(0)
    Unit cur, nxt; int ui = 0;
    if (!S.next(0, cur)) return;
    f32x4 acc[2][2][4][2];
#pragma unroll
    for (int a = 0; a < 2; ++a)
#pragma unroll
        for (int b = 0; b < 2; ++b)
#pragma unroll
            for (int m = 0; m < 4; ++m)
#pragma unroll
                for (int n = 0; n < 2; ++n) acc[a][b][m][n] = (f32x4){0.f, 0.f, 0.f, 0.f};
    bf16x8 At[4][2], B0[2][2], B1[2][2];
    const char* cA = (const char*)g.A + (size_t)cur.pm * tstep; const char* cB = (const char*)g.Bt + (size_t)cur.pn * tstep;
    S.a_ready(cur);
    if constexpr (SP2) {
        PG8_STAGE(PG8_SB(0, 0), cB, voffB); PG8_STAGE(PG8_SB(0, 1), cB + hstep, voffB); PG8_STAGE(PG8_SA(0, 0), cA, voffA); PG8_STAGE(PG8_SA(0, 1), cA + hstep, voffA);
        if (wr == 1) PG8_BAR;
        PG8_WAIT_V(2); PG8_BAR;
        PG8_STAGE(PG8_SB(1, 0), cB + kstep, voffB); PG8_STAGE(PG8_SA(1, 0), cA + kstep, voffA); PG8_STAGE(PG8_SB(1, 1), cB + hstep + kstep, voffB);
        PG8_WAIT_V(6); PG8_BAR;
    } else {
        PG8_STAGE(PG8_SB(0, 0), cB, voffB); PG8_STAGE(PG8_SA(0, 0), cA, voffA); PG8_STAGE(PG8_SB(0, 1), cB + hstep, voffB); PG8_STAGE(PG8_SA(0, 1), cA + hstep, voffA);
        if (wr == 1) PG8_BAR;
        PG8_WAIT_V(4); PG8_BAR;
        PG8_STAGE(PG8_SB(1, 0), cB + kstep, voffB); PG8_STAGE(PG8_SA(1, 0), cA + kstep, voffA); PG8_STAGE(PG8_SB(1, 1), cB + hstep + kstep, voffB);
        PG8_WAIT_V(6); PG8_BAR;
    }
    for (;;) {
        const bool has_next = S.next(ui + 1, nxt);
        const char* nA = has_next ? (const char*)g.A + (size_t)nxt.pm * tstep : cA; const char* nB = has_next ? (const char*)g.Bt + (size_t)nxt.pn * tstep : cB;
        for (int t = 0; t < nt; t += 2) {
            const bool last = (t == nt - 2);
            const char* a1 = cA + (size_t)(t + 1) * kstep;
            const char* a2 = last ? nA : cA + (size_t)(t + 2) * kstep; const char* b2 = last ? nB : cB + (size_t)(t + 2) * kstep;
            const char* a3 = a2 + kstep; const char* b3 = b2 + kstep;
            if (last && has_next) S.a_ready(nxt);
            if constexpr (SP2) {
            PG8_LDB(B0, 0, 0); PG8_LDB(B1, 0, 1); PG8_SCHED; PG8_LDA(At, 0, 0); PG8_STAGE(PG8_SA(1, 1), a1 + hstep, voffA);
            PG8_WAIT_V(8); PG8_WAIT_L(0); PG8_BAR; PG8_MMA(0, 0, At, B0); PG8_MMA(0, 1, At, B1); PG8_BAR; PG8_SCHED;
            PG8_LDA(At, 0, 1); PG8_STAGE(PG8_SB(0, 0), b2, voffB); PG8_STAGE(PG8_SB(0, 1), b2 + hstep, voffB); PG8_STAGE(PG8_SA(0, 0), a2, voffA);
            PG8_WAIT_V(8); PG8_WAIT_L(0); PG8_BAR; PG8_MMA(1, 0, At, B0); PG8_MMA(1, 1, At, B1); PG8_BAR; PG8_SCHED;
            PG8_LDB(B0, 1, 0); PG8_LDB(B1, 1, 1); PG8_SCHED; PG8_LDA(At, 1, 0); PG8_STAGE(PG8_SA(0, 1), a2 + hstep, voffA);
            PG8_WAIT_V(8); PG8_WAIT_L(0); PG8_BAR; PG8_MMA(0, 0, At, B0); PG8_MMA(0, 1, At, B1); PG8_BAR; PG8_SCHED;
            PG8_LDA(At, 1, 1); PG8_STAGE(PG8_SB(1, 0), b3, voffB); PG8_STAGE(PG8_SB(1, 1), b3 + hstep, voffB); PG8_STAGE(PG8_SA(1, 0), a3, voffA);
            PG8_WAIT_V(8); PG8_WAIT_L(0); PG8_BAR; PG8_MMA(1, 0, At, B0); PG8_MMA(1, 1, At, B1); PG8_BAR; PG8_SCHED;
            } else {
            PG8_LDB(B0, 0, 0); PG8_SCHED; PG8_LDA(At, 0, 0); PG8_STAGE(PG8_SA(1, 1), a1 + hstep, voffA);
            PG8_WAIT_L(8); PG8_BAR; PG8_WAIT_L(0); PG8_MMA(0, 0, At, B0); PG8_BAR; PG8_SCHED;
            PG8_LDB(B1, 0, 1); PG8_STAGE(PG8_SB(0, 0), b2, voffB);
            PG8_BAR; PG8_WAIT_L(0); PG8_MMA(0, 1, At, B1); PG8_BAR;
            PG8_LDA(At, 0, 1); PG8_STAGE(PG8_SA(0, 0), a2, voffA);
            PG8_BAR; PG8_WAIT_L(0); PG8_MMA(1, 0, At, B0); PG8_BAR; PG8_SCHED;
            PG8_STAGE(PG8_SB(0, 1), b2 + hstep, voffB);
            PG8_WAIT_V(6); PG8_BAR; PG8_MMA(1, 1, At, B1); PG8_BAR;
            PG8_LDB(B0, 1, 0); PG8_SCHED; PG8_LDA(At, 1, 0); PG8_STAGE(PG8_SA(0, 1), a2 + hstep, voffA);
            PG8_WAIT_L(8); PG8_BAR; PG8_WAIT_L(0); PG8_MMA(0, 0, At, B0); PG8_BAR; PG8_SCHED;
            PG8_LDB(B1, 1, 1); PG8_STAGE(PG8_SB(1, 0), b3, voffB);
            PG8_BAR; PG8_WAIT_L(0); PG8_MMA(0, 1, At, B1); PG8_BAR;
            PG8_LDA(At, 1, 1); PG8_STAGE(PG8_SA(1, 0), a3, voffA);
            PG8_BAR; PG8_WAIT_L(0); PG8_MMA(1, 0, At, B0); PG8_BAR; PG8_SCHED;
            PG8_STAGE(PG8_SB(1, 1), b3 + hstep, voffB);
            PG8_WAIT_V(6); PG8_BAR; PG8_MMA(1, 1, At, B1); PG8_BAR;
            }
        }
        if constexpr (ALIGN_EPI) { if (wr == 0) PG8_BAR; }
        if constexpr (!Epi::AFTER_DRAIN) { E(acc, cur, wr, wc, fr, fq); S.done(cur); }
        if (!has_next) break;
#pragma unroll
        for (int a = 0; a < 2; ++a)
#pragma unroll
            for (int b = 0; b < 2; ++b)
#pragma unroll
                for (int m = 0; m < 4; ++m)
#pragma unroll
                    for (int n = 0; n < 2; ++n) acc[a][b][m][n] = (f32x4){0.f, 0.f, 0.f, 0.f};
        cur = nxt; cA = nA; cB = nB; ++ui;
        if constexpr (ALIGN_EPI) { if (wr == 1) PG8_BAR; }
    }
    PG8_WAIT_V(0);
    if constexpr (!ALIGN_EPI) { if (wr == 0) PG8_BAR; }
    PG8_BAR;
    if constexpr (Epi::AFTER_DRAIN) { E.fused(acc, cur, wr, wc, fr, fq, lds, wid, lane); S.done(cur); }
#undef PG8_SA
#undef PG8_SB
#undef PG8_STAGE
#undef PG8_LDA
#undef PG8_LDB
#undef PG8_MMA
#undef PG8_WAIT_V
#undef PG8_WAIT_L
#undef PG8_BAR
#undef PG8_SCHED
}
}
#define GAS __attribute__((address_space(1)))
#define LAS __attribute__((address_space(3)))
typedef unsigned short bf16;
typedef unsigned v4u __attribute__((ext_vector_type(4)));
typedef float f32x4 __attribute__((ext_vector_type(4)));
typedef short bf16x8 __attribute__((ext_vector_type(8)));
typedef GAS unsigned gu32;
typedef GAS unsigned long long gu64;
#define RLX_AGENT __ATOMIC_RELAXED, __HIP_MEMORY_SCOPE_AGENT
#define LDS_WAIT() asm volatile("s_waitcnt lgkmcnt(0)" ::: "memory")
#define VM_WAIT() asm volatile("s_waitcnt vmcnt(0)" ::: "memory")
__device__ __forceinline__ unsigned long long rt() { return __builtin_amdgcn_s_memrealtime(); }
__device__ __forceinline__ unsigned f2bf(float f) { unsigned u = __builtin_bit_cast(unsigned, f); return (u + 0x7fffu + ((u >> 16) & 1u)) >> 16; }
__device__ __forceinline__ unsigned pk2(float lo, float hi) { return f2bf(lo) | (f2bf(hi) << 16); }

#define XB_TMO      128
#define XB_XCNT(j)  (256  + 64 * (j))
#define XB_XSUB(j)  (1280 + 64 * (j))
#define XB_XGEN(j)  (2304 + 64 * (j))
#define XB_TOP      3328
#define XB_TOPGEN   3392
#define XCD_BAR_WORDS 3456
#define XB_SPIN_CAP (1u << 18)

__device__ __forceinline__ unsigned xb_ld(unsigned* p)              { return __hip_atomic_load(p, __ATOMIC_RELAXED, __HIP_MEMORY_SCOPE_AGENT); }
__device__ __forceinline__ unsigned xb_add(unsigned* p, unsigned v) { return __hip_atomic_fetch_add(p, v, __ATOMIC_RELAXED, __HIP_MEMORY_SCOPE_AGENT); }
__device__ __forceinline__ unsigned xb_xcc_id() { return (unsigned)__builtin_amdgcn_s_getreg((3 << 11) | 20) & 0xFu; }
#define XB_SPIN(cond, bar) do { unsigned _sp = 0; while (cond) { __builtin_amdgcn_s_sleep(1); \
    if ((++_sp & 255u) == 0u) { if (xb_ld(&(bar)[XB_TMO])) break; if (_sp > XB_SPIN_CAP) { atomicAdd(&(bar)[XB_TMO], 1u); break; } } } } while (0)

struct XcdBarrier {
    unsigned* bar; unsigned x;
    volatile LAS unsigned* st;
};

__device__ __forceinline__ XcdBarrier xcd_barrier_post(unsigned* bar, volatile LAS unsigned* st) {
    XcdBarrier b; b.bar = bar; b.x = xb_xcc_id(); b.st = st;
    if (threadIdx.x == 0) (void)xb_add(&bar[XB_XCNT(b.x)], 1u);
    return b;
}
__device__ __forceinline__ void xcd_barrier_complete(unsigned* bar, unsigned x, unsigned& nloc, unsigned& nx) {
    const unsigned G = gridDim.x * gridDim.y * gridDim.z;
    unsigned sum, cnt, mine, sp = 0u;
    for (;;) {
        sum = 0u; cnt = 0u; mine = 0u;
#pragma unroll
        for (unsigned j = 0; j < 16; ++j) { const unsigned c = xb_ld(&bar[XB_XCNT(j)]); sum += c; cnt += (c > 0u) ? 1u : 0u; mine = (j == x) ? c : mine; }
        if (sum == G) break;
        __builtin_amdgcn_s_sleep(1);
        if ((++sp & 255u) == 0u) { if (xb_ld(&bar[XB_TMO])) break; if (sp > XB_SPIN_CAP) { atomicAdd(&bar[XB_TMO], 1u); break; } }
    }
    nloc = mine > 0u ? mine : 1u; nx = cnt > 0u ? cnt : 1u;
}

__device__ __forceinline__ void xcd_barrier(const XcdBarrier& b) {
    asm volatile("s_waitcnt vmcnt(0)" ::: "memory");
    __syncthreads();
    if (threadIdx.x == 0) {
        unsigned* bar = b.bar;
        __builtin_amdgcn_s_waitcnt(0);
        unsigned nloc = b.st[0], nx = b.st[1];
        if (nloc == 0u) { xcd_barrier_complete(bar, b.x, nloc, nx); b.st[0] = nloc; b.st[1] = nx; }
        const unsigned old = xb_add(&bar[XB_XSUB(b.x)], 1u);
        const unsigned gen = old / nloc;
        if (old + 1u == (gen + 1u) * nloc) {
            __builtin_amdgcn_fence(__ATOMIC_RELEASE, "agent");
            asm volatile("s_waitcnt vmcnt(0)" ::: "memory");
            const unsigned og = xb_add(&bar[XB_TOP], 1u);
            const unsigned tg = og / nx;
            if (og + 1u == (tg + 1u) * nx) xb_add(&bar[XB_TOPGEN], 1u);
            else XB_SPIN(xb_ld(&bar[XB_TOPGEN]) == tg, bar);
            __builtin_amdgcn_fence(__ATOMIC_ACQUIRE, "agent");
            xb_add(&bar[XB_XGEN(b.x)], 1u);
            asm volatile("s_waitcnt vmcnt(0)" ::: "memory");
        } else {
            XB_SPIN(xb_ld(&bar[XB_XGEN(b.x)]) == gen, bar);
            __builtin_amdgcn_fence(__ATOMIC_ACQUIRE, "agent");
            asm volatile("s_waitcnt vmcnt(0)" ::: "memory");
        }
    }
    __syncthreads();
}
__device__ __forceinline__ float bf2f(unsigned short h) { return __builtin_bit_cast(float, (unsigned)h << 16); }
using pg8::M_P; using pg8::M_S; using pg8::M_TOT; using pg8::MR; using pg8::DM; using pg8::NPROJ; using pg8::DA;
constexpr int NWAVES = 8;
constexpr int SEQ = 8192, NHEAD = 16, HD = 64, NGRP = 64, NST = 64, NCH = 16;
constexpr float LN_EPS = 1e-5f;
constexpr float DN_ALPHA = 1.189207115002721f;
constexpr size_t MiB = 1u << 20;
constexpr size_t WS_CTL = 0, CTL_ZERO_BYTES = 1 * MiB;
constexpr size_t WS_WIN = 2 * MiB;
constexpr size_t WS_WGLU = 26 * MiB;
constexpr size_t WS_WOUT = 28 * MiB;
constexpr size_t WS_SA = 36 * MiB;
constexpr size_t WS_BBAR = 37 * MiB;
constexpr size_t WS_XB = 64 * MiB;
constexpr size_t WS_H = 136 * MiB;
constexpr size_t WS_BR = 336 * MiB;
constexpr size_t WS_Z = 404 * MiB;
constexpr size_t WS_END = 440 * MiB;
constexpr size_t HREG = (size_t)MR * DA;
constexpr size_t O_YP = 0, O_YS = 33554432, O_KP = 33816576, O_VP = 38010880, O_SRP = 42205184, O_SIP = 42213376,
                 O_KS = 42221568, O_VS = 42352640, O_SRS = 42483712, O_SIS = 42614784, O_TOTAL = 42745856;
constexpr int CW_TMO = 0, CW_CODE = 1, CW_BAR = 4096, CW_Q = 16384;
constexpr int RING_OFF = 0, RING_BYTES = 131072;
constexpr int LDSCTL_OFF = 163328, MISC_OFF = LDSCTL_OFF + 320;
constexpr int LDS_BYTES = 163840;
struct Frame {
    LAS unsigned char* lds;
    volatile LAS unsigned* MISC;
    gu32* ctl;
    int tid, lane, wave;
    int vcu, G;
    const float* in[22]; float* out; unsigned char* ws;
};
__device__ __forceinline__ float wave_sum(float v) {
#pragma unroll
    for (int o = 1; o < 64; o <<= 1) v += __shfl_xor(v, o);
    return v;
}
__device__ __forceinline__ void p0_transpose_item(const float* W, int K, int N, bf16* WT, LAS float* scr, int item, int lane) {
    const int nblk = N / 32, kb = item / nblk, nb = item % nblk, k0 = 64 * kb, n0 = 32 * nb;
#pragma unroll 8
    for (int i = 0; i < 32; ++i) { const int kk = 2 * i + (lane >> 5); scr[kk * 33 + (lane & 31)] = W[(size_t)(k0 + kk) * N + n0 + (lane & 31)]; }
    LDS_WAIT(); asm volatile("" ::: "memory");
    const int c = lane & 7;
#pragma unroll
    for (int j = 0; j < 4; ++j) { const int n = (lane >> 3) + 8 * j; const LAS float* s = scr + (8 * c) * 33 + n;
        v4u o; o.x = pk2(s[0 * 33], s[1 * 33]); o.y = pk2(s[2 * 33], s[3 * 33]); o.z = pk2(s[4 * 33], s[5 * 33]); o.w = pk2(s[6 * 33], s[7 * 33]);
        *(GAS v4u*)(WT + (size_t)(n0 + n) * K + k0 + 8 * c) = o; }
    LDS_WAIT(); asm volatile("" ::: "memory");
}
__device__ __forceinline__ void sincos_d(double x, double& s, double& c) {
    const double TWO_PI = 6.283185307179586476925286766559;
    const double k = rint(x / TWO_PI);
    const double r = fma(-k, TWO_PI, x);
    const double y = r * 0.125, y2 = y * y;
    double sn = y * (1.0 - y2 / 6.0 * (1.0 - y2 / 20.0 * (1.0 - y2 / 42.0 * (1.0 - y2 / 72.0 * (1.0 - y2 / 110.0 * (1.0 - y2 / 156.0 * (1.0 - y2 / 210.0)))))));
    double cs = 1.0 - y2 / 2.0 * (1.0 - y2 / 12.0 * (1.0 - y2 / 30.0 * (1.0 - y2 / 56.0 * (1.0 - y2 / 90.0 * (1.0 - y2 / 132.0 * (1.0 - y2 / 182.0 * (1.0 - y2 / 240.0)))))));
#pragma unroll
    for (int i = 0; i < 3; ++i) { const double s2 = 2.0 * sn * cs, c2 = cs * cs - sn * sn; sn = s2; cs = c2; }
    s = sn; c = cs;
}
__device__ __forceinline__ void p0_prologue(Frame& F) {
    LAS float* scr = (LAS float*)(F.lds + RING_OFF + F.wave * 16384);
    const int gw = F.vcu * NWAVES + F.wave, NGW = F.G * NWAVES;
    constexpr int I_IN = (DM / 64) * (NPROJ / 32), I_GLU = (1024 / 64) * (1024 / 32), I_OUT = (DM / 64) * (DM / 32);
    constexpr int NITEMS = I_IN + I_GLU + I_OUT;
    for (int it = gw; it < NITEMS; it += NGW) {
        int r = it;
        if (r < I_IN) { p0_transpose_item(F.in[6], DM, NPROJ, (bf16*)(F.ws + WS_WIN), scr, r, F.lane); continue; } r -= I_IN;
        if (r < I_GLU) { p0_transpose_item(F.in[18], 1024, 1024, (bf16*)(F.ws + WS_WGLU), scr, r, F.lane); continue; } r -= I_GLU;
        p0_transpose_item(F.in[7], DM, DM, (bf16*)(F.ws + WS_WOUT), scr, r, F.lane);
    }
    bf16* XB = (bf16*)(F.ws + WS_XB);
    for (int m = gw; m < MR; m += NGW) {
        GAS unsigned long long* o8 = (GAS unsigned long long*)(XB + (size_t)m * DM) + F.lane;
        if (m < M_TOT) {
            const float* xrow = m < M_P ? F.in[0] + (size_t)m * DM : F.in[1] + (size_t)(m - M_P) * DM;
            const GAS f32x4* xr = (const GAS f32x4*)xrow + F.lane;
#pragma unroll
            for (int j = 0; j < 8; ++j) { const f32x4 v = xr[64 * j]; o8[64 * j] = (unsigned long long)pk2(v.x, v.y) | ((unsigned long long)pk2(v.z, v.w) << 32); }
        } else {
#pragma unroll
            for (int j = 0; j < 8; ++j) o8[64 * j] = 0ull;
        }
    }
    const int gt = F.vcu * (NWAVES * 64) + F.tid;
    if (gt < NGRP * NST) {
        const int g = gt >> 6;
        const double lr = fmin((double)F.in[10][gt], -1e-4), li = (double)F.in[11][gt];
        const double dt = exp((double)F.in[12][g]);
        const double mag = exp(lr * dt); double sn, cs; sincos_d(li * dt, sn, cs);
        double ar = mag * cs, ai = mag * sn;
        const double den = lr * lr + li * li, inv_re = lr / den, inv_im = -li / den;
        const double n_re = ar - 1.0, n_im = ai;
        const double cf_re = n_re * inv_re - n_im * inv_im, cf_im = n_re * inv_im + n_im * inv_re;
        float* SA = (float*)(F.ws + WS_SA) + (size_t)gt * 8;
        SA[0] = (float)ar; SA[1] = (float)ai;
        double pr = ar, pi = ai;
        for (int i = 0; i < 10; ++i) { const double t = pr * pr - pi * pi; pi = 2.0 * pr * pi; pr = t; if (i == 4) { SA[2] = (float)pr; SA[3] = (float)pi; } }
        SA[4] = (float)pr; SA[5] = (float)pi; SA[6] = 0.f; SA[7] = 0.f;
        float* BB = (float*)(F.ws + WS_BBAR) + (size_t)gt * 32;
        const float* br = F.in[13] + (size_t)gt * 16; const float* bi = F.in[14] + (size_t)gt * 16;
        for (int c = 0; c < 16; ++c) { const double x = br[c], y = bi[c]; BB[2 * c] = (float)(cf_re * x - cf_im * y); BB[2 * c + 1] = (float)(cf_re * y + cf_im * x); }
    }
}
__device__ __forceinline__ int t5_bucket(int dist) {
    if (dist < 16) return dist;
    const float v = logf((float)dist / 16.0f) / 4.852030263919617f * 16.0f;
    const int large = 16 + (int)v;
    return large < 31 ? large : 31;
}
__device__ __forceinline__ float gelu_tanh(float y) {
    const float a = 0.7978845608028654f * (y + 0.044715f * y * y * y);
    const float t = __expf(2.0f * a);
    return 0.5f * y * (2.0f - 2.0f * __builtin_amdgcn_rcpf(t + 1.0f));
}
template <bool SAMPLE>
__device__ __forceinline__ void attn_simple_task(Frame& F, int task, const LAS int* bkt) {
    const int h = task & 15, rowi = task >> 4;
    const bf16* Hq = (const bf16*)(F.ws + WS_H);
    const size_t qrow = SAMPLE ? (size_t)(M_P + rowi) : (size_t)rowi;
    const int b = SAMPLE ? (rowi >> 2) : (rowi >> 13), t = SAMPLE ? (2048 + (rowi & 3)) : (rowi & 8191);
    unsigned qp[32];
    { const v4u* qv = (const v4u*)(Hq + qrow * DA + h * HD);
#pragma unroll
      for (int i = 0; i < 8; ++i) { const v4u w = qv[i]; qp[4 * i] = w.x; qp[4 * i + 1] = w.y; qp[4 * i + 2] = w.z; qp[4 * i + 3] = w.w; } }
    const bf16* Kb = Hq + HREG; const bf16* Vb = Hq + 2 * HREG;
    const float* ck = F.in[2]; const float* cv = F.in[3]; const float* kn = F.out + O_KS; const float* vn = F.out + O_VS;
    LAS float* lgs = (LAS float*)(F.lds + RING_OFF + 4096 + F.wave * 2048);
    float mx = -INFINITY;
#pragma unroll 1
    for (int i = 0; i < 7; ++i) {
        const int e = F.lane + 64 * i; float v = -INFINITY;
        if (e < 387) {
            const int p = e / 129, j = e - p * 129, d = p == 0 ? 1 : (p == 1 ? 4 : 16), kt = t - j * d;
            if (kt >= 0) {
                float dot = 0.f;
                if (SAMPLE) {
                    const float* kr = kt < 2048 ? ck + (((size_t)b * 2048 + kt) * NHEAD + h) * HD : kn + ((size_t)(b * 4 + kt - 2048)) * DA + h * HD;
#pragma unroll
                    for (int c = 0; c < 16; ++c) { const f32x4 kv = *(const f32x4*)(kr + 4 * c); const unsigned q0 = qp[2 * c], q1 = qp[2 * c + 1];
                        dot += __builtin_bit_cast(float, q0 << 16) * kv.x + __builtin_bit_cast(float, q0 & 0xffff0000u) * kv.y + __builtin_bit_cast(float, q1 << 16) * kv.z + __builtin_bit_cast(float, q1 & 0xffff0000u) * kv.w; }
                } else {
                    const v4u* kr = (const v4u*)(Kb + ((size_t)b * SEQ + kt) * DA + h * HD);
#pragma unroll
                    for (int c = 0; c < 8; ++c) { const v4u kw = kr[c];
#pragma unroll
                        for (int x = 0; x < 4; ++x) { const unsigned kk = kw[x], qq = qp[4 * c + x];
                            dot += __builtin_bit_cast(float, qq << 16) * __builtin_bit_cast(float, kk << 16) + __builtin_bit_cast(float, qq & 0xffff0000u) * __builtin_bit_cast(float, kk & 0xffff0000u); } }
                }
                v = dot + F.in[9][bkt[e] * NHEAD + h] * 1.4426950408889634f;
            }
            lgs[e] = v;
        }
        mx = fmaxf(mx, v);
    }
#pragma unroll
    for (int o = 1; o < 64; o <<= 1) mx = fmaxf(mx, __shfl_xor(mx, o));
    float sum = 0.f;
#pragma unroll 1
    for (int i = 0; i < 7; ++i) { const int e = F.lane + 64 * i; if (e < 387) { const float pr = exp2f(lgs[e] - mx); lgs[e] = pr; sum += pr; } }
    sum = wave_sum(sum);
    LDS_WAIT(); asm volatile("" ::: "memory");
    float acc = 0.f;
#pragma unroll 1
    for (int p = 0; p < 3; ++p) {
        const int d = p == 0 ? 1 : (p == 1 ? 4 : 16);
#pragma unroll 4
        for (int j = 0; j < 129; ++j) {
            const int kt = t - j * d;
            if (kt < 0) break;
            const float pe = lgs[p * 129 + j];
            float vv;
            if (SAMPLE) vv = kt < 2048 ? cv[(((size_t)b * 2048 + kt) * NHEAD + h) * HD + F.lane] : vn[((size_t)(b * 4 + kt - 2048)) * DA + h * HD + F.lane];
            else vv = bf2f(Vb[((size_t)b * SEQ + kt) * DA + h * HD + F.lane]);
            acc += pe * vv;
        }
    }
    LDS_WAIT(); asm volatile("" ::: "memory");
    const float ga = bf2f(Hq[3 * HREG + qrow * DA + h * HD + F.lane]);
    ((bf16*)(F.ws + WS_BR))[qrow * 2048 + h * HD + F.lane] = (bf16)f2bf(acc / sum * ga);
}
__device__ __forceinline__ void ssm_seq(Frame& F, int g, size_t rowbase, int L, const float* x0r, const float* x0i, float* outr, float* outi) {
    const int n = F.lane;
    const float* SA = (const float*)(F.ws + WS_SA) + (size_t)(g * NST + n) * 8;
    const float ar = SA[0], ai = SA[1];
    const float* BB = (const float*)(F.ws + WS_BBAR) + (size_t)(g * NST + n) * 32;
    float bbr[16], bbi[16], cre[16], cim[16];
#pragma unroll
    for (int c = 0; c < 16; ++c) { bbr[c] = BB[2 * c]; bbi[c] = BB[2 * c + 1]; cre[c] = F.in[15][(size_t)(g * NCH + c) * NST + n]; cim[c] = F.in[16][(size_t)(g * NCH + c) * NST + n]; }
    const float dsk = F.in[17][g * NCH + (n & 15)];
    float xr = x0r ? x0r[n] : 0.f, xi = x0i ? x0i[n] : 0.f;
    const bf16* U = (const bf16*)(F.ws + WS_H) + 4 * HREG; bf16* Z = (bf16*)(F.ws + WS_Z);
    for (int t = 0; t < L; ++t) {
        const size_t row = rowbase + t;
        const v4u* up = (const v4u*)(U + row * DA + g * NCH);
        const v4u u0 = up[0], u1 = up[1];
        float u[16];
#pragma unroll
        for (int c = 0; c < 4; ++c) { u[2 * c] = __builtin_bit_cast(float, u0[c] << 16); u[2 * c + 1] = __builtin_bit_cast(float, u0[c] & 0xffff0000u); u[8 + 2 * c] = __builtin_bit_cast(float, u1[c] << 16); u[9 + 2 * c] = __builtin_bit_cast(float, u1[c] & 0xffff0000u); }
        float bur = 0.f, bui = 0.f;
#pragma unroll
        for (int c = 0; c < 16; ++c) { bur += bbr[c] * u[c]; bui += bbi[c] * u[c]; }
        const float nxr = ar * xr - ai * xi + bur, nxi = ar * xi + ai * xr + bui;
        xr = nxr; xi = nxi;
        float yv = 0.f, uv = 0.f;
#pragma unroll
        for (int c = 0; c < 16; ++c) { const float s = wave_sum(cre[c] * xr - cim[c] * xi); if ((n & 15) == c) { yv = s; uv = u[c]; } }
        yv += dsk * uv;
        if (n < 16) Z[row * DA + g * NCH + n] = (bf16)f2bf(gelu_tanh(yv));
    }
    outr[n] = xr; outi[n] = xi;
}
__device__ __forceinline__ void ln_row_inplace(Frame& F, float* row) {
    GAS f32x4* xr = (GAS f32x4*)row + F.lane;
    f32x4 v[8]; float s = 0.f;
#pragma unroll
    for (int j = 0; j < 8; ++j) { v[j] = xr[64 * j]; s += (v[j].x + v[j].y) + (v[j].z + v[j].w); }
    const float mean = wave_sum(s) * (1.f / DM); float s2 = 0.f;
#pragma unroll
    for (int j = 0; j < 8; ++j) { v[j] = v[j] - mean; s2 += (v[j].x * v[j].x + v[j].y * v[j].y) + (v[j].z * v[j].z + v[j].w * v[j].w); }
    const float rstd = 1.f / sqrtf(wave_sum(s2) * (1.f / DM) + LN_EPS);
    const GAS f32x4* gp = (const GAS f32x4*)F.in[20] + F.lane; const GAS f32x4* bp = (const GAS f32x4*)F.in[21] + F.lane;
#pragma unroll
    for (int j = 0; j < 8; ++j) xr[64 * j] = v[j] * rstd * gp[64 * j] + bp[64 * j];
}
typedef float f32x16 __attribute__((ext_vector_type(16)));
typedef __bf16 bf16x2_t __attribute__((ext_vector_type(2)));
typedef float f32x2_t __attribute__((ext_vector_type(2)));
__device__ __forceinline__ unsigned cvtpk(float lo, float hi) { f32x2_t v = {lo, hi}; bf16x2_t b = __builtin_convertvector(v, bf16x2_t); return __builtin_bit_cast(unsigned, b); }
__device__ __forceinline__ bf16x8 pack8(float a0, float a1, float a2, float a3, float a4, float a5, float a6, float a7) {
    v4u w; w.x = cvtpk(a0, a1); w.y = cvtpk(a2, a3); w.z = cvtpk(a4, a5); w.w = cvtpk(a6, a7); return __builtin_bit_cast(bf16x8, w); }
constexpr int SSM_EP = 257;
constexpr int SSM_ST_OFF = 2 * 64 * SSM_EP * 4, SSM_A2T_OFF = SSM_ST_OFF + 4096, SSM_A1T_OFF = SSM_A2T_OFF + 8192, SSM_LDS_END = SSM_A1T_OFF + 5120;
__device__ __forceinline__ void ssm_fast_block(Frame& F, int b, int g) {
    const int lane = F.lane, w = F.wave, col = lane & 31, h = lane >> 5;
    LAS float* Ere = (LAS float*)(F.lds + RING_OFF); LAS float* Eim = Ere + 64 * SSM_EP;
    LAS float* ST = (LAS float*)(F.lds + RING_OFF + SSM_ST_OFF);
    LAS v4u* A2T = (LAS v4u*)(F.lds + RING_OFF + SSM_A2T_OFF);
    LAS v4u* A1T = (LAS v4u*)(F.lds + RING_OFF + SSM_A1T_OFF);
    const float* SA = (const float*)(F.ws + WS_SA) + (size_t)g * NST * 8;
    const float* BB = (const float*)(F.ws + WS_BBAR) + (size_t)g * NST * 32;
    const float* Cre = F.in[15] + (size_t)g * NCH * NST; const float* Cim = F.in[16] + (size_t)g * NCH * NST;
    float ar[2][16], ai[2][16];
#pragma unroll
    for (int s = 0; s < 2; ++s)
#pragma unroll
        for (int r = 0; r < 16; ++r) { const int n = 32 * s + (r & 3) + 8 * (r >> 2) + 4 * h; ar[s][r] = SA[n * 8]; ai[s][r] = SA[n * 8 + 1]; }
    if (w < 4) { const int tau = w; const int n = 32 * (tau >> 1) + col; float v[8];
#pragma unroll
        for (int jj = 0; jj < 8; ++jj) { const int ch = 4 * h + (jj & 3) + 8 * (jj >> 2); v[jj] = BB[n * 32 + 2 * ch + (tau & 1)]; }
        A1T[tau * 64 + lane] = __builtin_bit_cast(v4u, pack8(v[0], v[1], v[2], v[3], v[4], v[5], v[6], v[7])); }
    if (w == 4) { float v[8];
#pragma unroll
      for (int jj = 0; jj < 8; ++jj) { const int ch = 4 * h + (jj & 3) + 8 * (jj >> 2); v[jj] = (col < 16 && ch == col) ? F.in[17][g * NCH + col] : 0.f; }
      A1T[4 * 64 + lane] = __builtin_bit_cast(v4u, pack8(v[0], v[1], v[2], v[3], v[4], v[5], v[6], v[7])); }
    { const int tau = w >> 1, s = w & 1; float v[8];
#pragma unroll
      for (int jj = 0; jj < 8; ++jj) { const int n = 32 * (tau >> 1) + 16 * s + 8 * (jj >> 2) + 4 * h + (jj & 3);
          v[jj] = col < 16 ? ((tau & 1) ? -Cim[col * NST + n] : Cre[col * NST + n]) : 0.f; }
      A2T[w * 64 + lane] = __builtin_bit_cast(v4u, pack8(v[0], v[1], v[2], v[3], v[4], v[5], v[6], v[7])); }
    __syncthreads();
#define A1F(k) __builtin_bit_cast(bf16x8, A1T[(k) * 64 + lane])
    const size_t row0 = (size_t)b * SEQ + 32 * (32 * w + col);
    const bf16* Up = (const bf16*)(F.ws + WS_H) + 4 * HREG + row0 * DA + g * NCH + 4 * h;
    bf16* Zp = (bf16*)(F.ws + WS_Z) + row0 * DA + g * NCH + 4 * h;
    typedef unsigned long long u64x2 __attribute__((ext_vector_type(2)));
#define SSM_LOADU(t) ({ u64x2 _q; _q.x = *(const GAS unsigned long long*)(Up + (size_t)(t) * DA); _q.y = *(const GAS unsigned long long*)(Up + (size_t)(t) * DA + 8); __builtin_bit_cast(bf16x8, _q); })
    float xr[2][16], xi[2][16];
#pragma unroll
    for (int s = 0; s < 2; ++s)
#pragma unroll
        for (int r = 0; r < 16; ++r) { xr[s][r] = 0.f; xi[s][r] = 0.f; }
    const f32x16 zero16 = {0.f, 0.f, 0.f, 0.f, 0.f, 0.f, 0.f, 0.f, 0.f, 0.f, 0.f, 0.f, 0.f, 0.f, 0.f, 0.f};
    {
        bf16x8 B1 = SSM_LOADU(0);
#pragma unroll 1
        for (int t = 0; t < 32; ++t) {
            asm volatile("" ::: "memory");
            const bf16x8 Bn = SSM_LOADU(t < 31 ? t + 1 : 31);
#pragma unroll
            for (int s = 0; s < 2; ++s) {
                const f32x16 bre = __builtin_amdgcn_mfma_f32_32x32x16_bf16(A1F(2 * s), B1, zero16, 0, 0, 0);
                const f32x16 bim = __builtin_amdgcn_mfma_f32_32x32x16_bf16(A1F(2 * s + 1), B1, zero16, 0, 0, 0);
#pragma unroll
                for (int r = 0; r < 16; ++r) { const float nr = ar[s][r] * xr[s][r] - ai[s][r] * xi[s][r] + bre[r], ni = ar[s][r] * xi[s][r] + ai[s][r] * xr[s][r] + bim[r]; xr[s][r] = nr; xi[s][r] = ni; }
            }
            B1 = Bn;
        }
    }
    { const int c = 32 * w + col;
#pragma unroll
      for (int s = 0; s < 2; ++s)
#pragma unroll
          for (int r = 0; r < 16; ++r) { const int n = 32 * s + (r & 3) + 8 * (r >> 2) + 4 * h; Ere[n * SSM_EP + c] = xr[s][r]; Eim[n * SSM_EP + c] = xi[s][r]; } }
    __syncthreads();
    {
        const int n = lane; const float a32r = SA[n * 8 + 2], a32i = SA[n * 8 + 3], a1kr = SA[n * 8 + 4], a1ki = SA[n * 8 + 5];
        float cr = 0.f, ci = 0.f;
#pragma unroll 4
        for (int k = 0; k < 32; ++k) { const int idx = n * SSM_EP + 32 * w + k; const float tr = Ere[idx], ti = Eim[idx]; Ere[idx] = cr; Eim[idx] = ci;
            const float nr = a32r * cr - a32i * ci + tr, ni = a32r * ci + a32i * cr + ti; cr = nr; ci = ni; }
        ST[(w * 64 + n) * 2] = cr; ST[(w * 64 + n) * 2 + 1] = ci;
        __syncthreads();
        float pr = 0.f, pi = 0.f;
        for (int w2 = 0; w2 < w; ++w2) { const float tr = ST[(w2 * 64 + n) * 2], ti = ST[(w2 * 64 + n) * 2 + 1]; const float nr = a1kr * pr - a1ki * pi + tr, ni = a1kr * pi + a1ki * pr + ti; pr = nr; pi = ni; }
#pragma unroll 4
        for (int k = 0; k < 32; ++k) { const int idx = n * SSM_EP + 32 * w + k; Ere[idx] += pr; Eim[idx] += pi; const float nr = a32r * pr - a32i * pi, ni = a32r * pi + a32i * pr; pr = nr; pi = ni; }
    }
    __syncthreads();
    { const int c = 32 * w + col;
#pragma unroll
      for (int s = 0; s < 2; ++s)
#pragma unroll
          for (int r = 0; r < 16; ++r) { const int n = 32 * s + (r & 3) + 8 * (r >> 2) + 4 * h; xr[s][r] = Ere[n * SSM_EP + c]; xi[s][r] = Eim[n * SSM_EP + c]; } }
    {
        bf16x8 B1 = SSM_LOADU(0);
#pragma unroll 1
        for (int t = 0; t < 32; ++t) {
            asm volatile("" ::: "memory");
            const bf16x8 Bn = SSM_LOADU(t < 31 ? t + 1 : 31);
            f32x16 Y = __builtin_amdgcn_mfma_f32_32x32x16_bf16(A1F(4), B1, zero16, 0, 0, 0);
#pragma unroll
            for (int s = 0; s < 2; ++s) {
                const f32x16 bre = __builtin_amdgcn_mfma_f32_32x32x16_bf16(A1F(2 * s), B1, zero16, 0, 0, 0);
                const f32x16 bim = __builtin_amdgcn_mfma_f32_32x32x16_bf16(A1F(2 * s + 1), B1, zero16, 0, 0, 0);
#pragma unroll
                for (int r = 0; r < 16; ++r) { const float nr = ar[s][r] * xr[s][r] - ai[s][r] * xi[s][r] + bre[r], ni = ar[s][r] * xi[s][r] + ai[s][r] * xr[s][r] + bim[r]; xr[s][r] = nr; xi[s][r] = ni; }
#pragma unroll
                for (int q = 0; q < 2; ++q) {
                    const bf16x8 fre = pack8(xr[s][8 * q], xr[s][8 * q + 1], xr[s][8 * q + 2], xr[s][8 * q + 3], xr[s][8 * q + 4], xr[s][8 * q + 5], xr[s][8 * q + 6], xr[s][8 * q + 7]);
                    const bf16x8 fim = pack8(xi[s][8 * q], xi[s][8 * q + 1], xi[s][8 * q + 2], xi[s][8 * q + 3], xi[s][8 * q + 4], xi[s][8 * q + 5], xi[s][8 * q + 6], xi[s][8 * q + 7]);
                    const bf16x8 are = __builtin_bit_cast(bf16x8, A2T[(4 * s + q) * 64 + lane]);
                    const bf16x8 aim = __builtin_bit_cast(bf16x8, A2T[(4 * s + 2 + q) * 64 + lane]);
                    Y = __builtin_amdgcn_mfma_f32_32x32x16_bf16(are, fre, Y, 0, 0, 0);
                    Y = __builtin_amdgcn_mfma_f32_32x32x16_bf16(aim, fim, Y, 0, 0, 0);
                }
            }
            const unsigned long long z0 = (unsigned long long)cvtpk(gelu_tanh(Y[0]), gelu_tanh(Y[1])) | ((unsigned long long)cvtpk(gelu_tanh(Y[2]), gelu_tanh(Y[3])) << 32);
            const unsigned long long z1 = (unsigned long long)cvtpk(gelu_tanh(Y[4]), gelu_tanh(Y[5])) | ((unsigned long long)cvtpk(gelu_tanh(Y[6]), gelu_tanh(Y[7])) << 32);
            *(GAS unsigned long long*)(Zp + (size_t)t * DA) = z0; *(GAS unsigned long long*)(Zp + (size_t)t * DA + 8) = z1;
            B1 = Bn;
        }
    }
#undef SSM_LOADU
#undef A1F
    if (w == 7 && col == 31) {
        float* outr = F.out + O_SRP + (size_t)(b * NGRP + g) * NST; float* outi = F.out + O_SIP + (size_t)(b * NGRP + g) * NST;
#pragma unroll
        for (int s = 0; s < 2; ++s)
#pragma unroll
            for (int r = 0; r < 16; ++r) { const int n = 32 * s + (r & 3) + 8 * (r >> 2) + 4 * h; outr[n] = xr[s][r]; outi[n] = xi[s][r]; }
    }
    __syncthreads();
}
#ifndef MK_N_LAUNCHES
#define MK_N_LAUNCHES 1
#endif
constexpr int N_PHASES = 6;
constexpr int N_LAUNCHES = MK_N_LAUNCHES;
struct Args { const float* in[22]; float* out; unsigned char* ws; int ph_lo, ph_hi, li, pad; };
__global__ void __launch_bounds__(NWAVES * 64, 2) fwd_kernel(Args args) {
    extern __shared__ __attribute__((aligned(16))) unsigned char lds[];
    Frame F;
    F.lds = (LAS unsigned char*)lds;
    F.MISC = (volatile LAS unsigned*)(F.lds + MISC_OFF);
    F.tid = threadIdx.x; F.lane = F.tid & 63; F.wave = __builtin_amdgcn_readfirstlane(F.tid >> 6);
    F.G = gridDim.x; { const int bx = blockIdx.x; F.vcu = (F.G % 8 == 0) ? (bx % 8) * (F.G / 8) + bx / 8 : bx; }
    F.ws = args.ws; F.out = args.out;
#pragma unroll
    for (int i = 0; i < 22; ++i) F.in[i] = args.in[i];
    F.ctl = (gu32*)(F.ws + WS_CTL);
    for (int u = F.tid; u < (LDS_BYTES - LDSCTL_OFF) / 4; u += NWAVES * 64) ((LAS unsigned*)(F.lds + LDSCTL_OFF))[u] = 0u;
    __syncthreads();
    XcdBarrier bar; bar.bar = (unsigned*)(F.ctl + CW_BAR); bar.x = 0; bar.st = nullptr;
    if (N_LAUNCHES == 1) bar = xcd_barrier_post((unsigned*)(F.ctl + CW_BAR), F.MISC + 8);
    const int lo = args.ph_lo, hi = args.ph_hi;
#define IN(k) (lo <= (k) && (k) < hi)
#define BOTH(k) (IN(k) && IN((k) + 1))
#define GRID_BAR() do { if (N_LAUNCHES == 1) xcd_barrier(bar); } while (0)

    if (IN(0)) { p0_prologue(F); if (BOTH(0)) GRID_BAR(); }
    if (IN(1)) {
        pg8::Gemm g{(const pg8::bf16_t*)(F.ws + WS_XB), (const pg8::bf16_t*)(F.ws + WS_WIN), MR, NPROJ, DM};
        pg8::StaticOrder S; S.init(MR, NPROJ, F.G, (int)blockIdx.x);
        pg8::EpiIn E{(pg8::bf16_t*)(F.ws + WS_H), F.out + O_KP, F.out + O_VP, F.out + O_KS, F.out + O_VS};
        pg8::gemm_phase<pg8::EpiIn, pg8::StaticOrder, true, true>(F.lds + RING_OFF, g, S, E);
        if (BOTH(1)) GRID_BAR();
    }

    if (IN(2)) {
        if (F.vcu < 2 * NGRP) ssm_fast_block(F, F.vcu >> 6, F.vcu & 63);
        LAS int* bkt = (LAS int*)(F.lds + RING_OFF);
        for (int e = F.tid; e < 387; e += NWAVES * 64) { const int p = e / 129, j = e - p * 129, d = p == 0 ? 1 : (p == 1 ? 4 : 16); bkt[e] = t5_bucket(j * d); }
        __syncthreads();
        const int gw = F.vcu * NWAVES + F.wave, NGW = F.G * NWAVES;
        for (int task = gw; task < 32 * NGRP; task += NGW) { const int db = task >> 6, g = task & 63;
            ssm_seq(F, g, (size_t)M_P + db * 4, 4, F.in[4] + (size_t)task * NST, F.in[5] + (size_t)task * NST, F.out + O_SRS + (size_t)task * NST, F.out + O_SIS + (size_t)task * NST); }
        for (int task = gw; task < M_S * NHEAD; task += NGW) attn_simple_task<true>(F, task, bkt);
        for (int task = gw; task < M_P * NHEAD; task += NGW) attn_simple_task<false>(F, task, bkt);
        if (BOTH(2)) GRID_BAR();
    }
    if (IN(3)) {
        pg8::Gemm g{(const pg8::bf16_t*)(F.ws + WS_Z), (const pg8::bf16_t*)(F.ws + WS_WGLU), MR, 1024, 1024};
        pg8::StaticOrder S; S.init(MR, 1024, F.G, (int)blockIdx.x);
        pg8::EpiGlu E{(const pg8::bf16_t*)(F.ws + WS_Z), (const pg8::bf16_t*)(F.ws + WS_H) + 5 * HREG, F.in[19], (pg8::bf16_t*)(F.ws + WS_BR)};
        pg8::gemm_phase<pg8::EpiGlu, pg8::StaticOrder, true, true>(F.lds + RING_OFF, g, S, E);
        if (BOTH(3)) GRID_BAR();
    }
    if (IN(4)) {
        pg8::Gemm g{(const pg8::bf16_t*)(F.ws + WS_BR), (const pg8::bf16_t*)(F.ws + WS_WOUT), MR, DM, DM};
        pg8::StaticOrder S; S.init(MR, DM, F.G, (int)blockIdx.x);
        pg8::EpiOut E{F.in[0], F.in[1], F.in[8], F.out + O_YP, F.out + O_YS, DN_ALPHA};
        pg8::gemm_phase<pg8::EpiOut, pg8::StaticOrder, true, true>(F.lds + RING_OFF, g, S, E);
        if (BOTH(4)) GRID_BAR();
    }
    if (IN(5)) {
        const int gw = F.vcu * NWAVES + F.wave, NGW = F.G * NWAVES;
        for (int m = gw; m < M_TOT; m += NGW) ln_row_inplace(F, m < M_P ? F.out + O_YP + (size_t)m * DM : F.out + O_YS + (size_t)(m - M_P) * DM);
    }
#undef IN
#undef BOTH
}

extern "C" void kernel_launch(void* const* d_in, const int* in_sizes, int n_in, void* d_out, int out_size, void* d_ws, size_t ws_size, hipStream_t stream) {
    static int grid = 0;
    if (grid == 0) {
        if (n_in != 22 || (size_t)out_size != O_TOTAL || ws_size < WS_END) { fprintf(stderr, "kernel_launch: unexpected shapes: n_in %d out %d ws %zu\n", n_in, out_size, ws_size); grid = -1; return; }
        int dev = 0, cus = 0, per_cu = 0;
        if (hipGetDevice(&dev) != hipSuccess || hipDeviceGetAttribute(&cus, hipDeviceAttributeMultiprocessorCount, dev) != hipSuccess) { grid = -1; return; }
        if (hipFuncSetAttribute((const void*)fwd_kernel, hipFuncAttributeMaxDynamicSharedMemorySize, LDS_BYTES) != hipSuccess) { fprintf(stderr, "kernel_launch: hipFuncSetAttribute failed\n"); grid = -1; return; }
        if (hipOccupancyMaxActiveBlocksPerMultiprocessor(&per_cu, (const void*)fwd_kernel, NWAVES * 64, LDS_BYTES) != hipSuccess || per_cu < 1) { fprintf(stderr, "kernel_launch: occupancy query says %d blocks/CU\n", per_cu); (void)hipGetLastError(); grid = -1; return; }
        grid = cus;
    }
    if (grid < 0) return;
    if (hipMemsetAsync((char*)d_ws + WS_CTL, 0, CTL_ZERO_BYTES, stream) != hipSuccess) return;
    Args a{};
    for (int i = 0; i < 22; ++i) a.in[i] = (const float*)d_in[i];
    a.out = (float*)d_out; a.ws = (unsigned char*)d_ws;
    for (int li = 0; li < N_LAUNCHES; ++li) {
        a.ph_lo = (N_LAUNCHES == 1) ? 0 : li; a.ph_hi = (N_LAUNCHES == 1) ? N_PHASES : li + 1; a.li = li;
        hipLaunchKernelGGL(fwd_kernel, dim3(grid), dim3(NWAVES * 64), LDS_BYTES, stream, a);
    }
}
```

```cpp
#include <hip/hip_runtime.h>
#include <cstdio>
#include <cstdint>
#include <cmath>
namespace pg8 {
#define PG8_LAS __attribute__((address_space(3)))
typedef unsigned short bf16_t;
typedef short bf16x8 __attribute__((ext_vector_type(8)));
typedef float f32x4 __attribute__((ext_vector_type(4)));
typedef unsigned u32x4 __attribute__((ext_vector_type(4)));
constexpr int BM = 256, BK = 64, HALF = 128, HTB = HALF * BK * 2  , STAGE_BYTES = 8 * HTB, NXCD = 8, WGM = 8;

__host__ __device__ __forceinline__ int lds_byte(int r, int c) { const int st = (r >> 4) * 2 + (c >> 5), rr = r & 15, cc = c & 31, ob = rr * 64 + cc * 2; return st * 1024 + (ob ^ (((ob >> 9) & 1) << 5)); }
__host__ __device__ __forceinline__ void stage_rc(int b, int& R, int& C) { const int st = b / 1024, sb = b % 1024, swz = sb ^ (((sb >> 9) & 1) << 5); R = (st >> 1) * 16 + swz / 64; C = (st & 1) * 32 + (swz % 64) / 2; }
__host__ __device__ __forceinline__ int perm32(int rho) { const int n = rho >> 4, i = rho & 15; return 8 * (i >> 2) + 4 * n + (i & 3); }

struct Unit { int pm, pn; };
struct Gemm { const bf16_t* A; const bf16_t* Bt; int M, N, K; };

struct StaticOrder {
    int nM, nN, nwg, G, c;
    __host__ __device__ void init(int M, int N, int G_, int c_) { nM = M / BM; nN = N / BM; nwg = nM * nN; G = G_; c = c_; }
    __host__ __device__ bool next(int i, Unit& u) const {
        const long L = (long)i * G + c; if (L >= nwg) return false;
        int wgid = (int)L; { const int q = nwg / NXCD, r = nwg % NXCD, xcd = wgid % NXCD, off = wgid / NXCD; wgid = (xcd < r ? xcd * (q + 1) : r * (q + 1) + (xcd - r) * q) + off; }
        const int nig = WGM * nN, gid = wgid / nig, fm = gid * WGM, gsz = (nM - fm) < WGM ? (nM - fm) : WGM;
        u.pm = fm + ((wgid % nig) % gsz); u.pn = (wgid % nig) / gsz; return true;
    }
    __device__ __forceinline__ void a_ready(const Unit&) const {}
    __device__ __forceinline__ void done(const Unit&) const {}
};

__device__ __forceinline__ unsigned cvt_pk_bf16(float lo, float hi) { unsigned r; asm volatile("v_cvt_pk_bf16_f32 %0, %1, %2" : "=v"(r) : "v"(lo), "v"(hi)); return r; }
__device__ __forceinline__ float silu_f(float v) { return v * __builtin_amdgcn_rcpf(1.0f + __expf(-v)); }
constexpr int M_P = 16384, M_S = 128, M_TOT = M_P + M_S, MR = 16640;
constexpr int DM = 2048, NPROJ = 6144, DA = 1024;
constexpr float QSCALE = 0.125f * 1.4426950408889634f;
typedef float f32x2 __attribute__((ext_vector_type(2)));

struct EpiIn {
    static constexpr bool PERM = true, AFTER_DRAIN = false;
    bf16_t* H; float* kp; float* vp; float* ks; float* vs;
    __device__ __forceinline__ void operator()(const f32x4 (&acc)[2][2][4][2], const Unit& u, int wr, int wc, int fr, int fq) const {
        const int region = u.pn >> 2, colt = (u.pn & 3) * BM;
        bf16_t* base = H + (size_t)region * ((size_t)MR * DA);
        const int row0 = u.pm * BM + wr * 64 + fr, col0 = colt + wc * 32 + 8 * fq;
        float* fo_p = region == 1 ? kp : vp; float* fo_s = region == 1 ? ks : vs;
#pragma unroll
        for (int ai = 0; ai < 2; ++ai)
#pragma unroll
            for (int m = 0; m < 4; ++m) {
                const int row = row0 + ai * HALF + m * 16;
                bf16_t* rowp = base + (size_t)row * DA + col0;
                float* frow = nullptr;
                if (region == 1 || region == 2) {
                    if (row < M_P) { const int b = row >> 13, t = row & 8191; if (t >= 6144) frow = fo_p + ((size_t)(b * 2048 + (t - 6144))) * DA + col0; }
                    else if (row < M_TOT) frow = fo_s + (size_t)(row - M_P) * DA + col0;
                }
#pragma unroll
                for (int bj = 0; bj < 2; ++bj) {
                    f32x4 v0 = acc[ai][bj][m][0], v1 = acc[ai][bj][m][1];
                    if (region == 0) { v0 = v0 * QSCALE; v1 = v1 * QSCALE; }
                    if (region == 3 || region == 5) {
#pragma unroll
                        for (int e = 0; e < 4; ++e) { v0[e] = silu_f(v0[e]); v1[e] = silu_f(v1[e]); }
                    }
                    u32x4 w; w.x = cvt_pk_bf16(v0[0], v0[1]); w.y = cvt_pk_bf16(v0[2], v0[3]); w.z = cvt_pk_bf16(v1[0], v1[1]); w.w = cvt_pk_bf16(v1[2], v1[3]);
                    *(u32x4*)(rowp + bj * HALF) = w;
                    if (frow) { *(f32x4*)(frow + bj * HALF) = v0; *(f32x4*)(frow + bj * HALF + 4) = v1; }
                }
            }
    }
};
struct EpiGlu {
    static constexpr bool PERM = true, AFTER_DRAIN = false;
    const bf16_t* Z; const bf16_t* GS; const float* bias; bf16_t* BR;
    __device__ __forceinline__ void operator()(const f32x4 (&acc)[2][2][4][2], const Unit& u, int wr, int wc, int fr, int fq) const {
        const int row0 = u.pm * BM + wr * 64 + fr, col0 = u.pn * BM + wc * 32 + 8 * fq;
        f32x4 bv[2][2];
#pragma unroll
        for (int bj = 0; bj < 2; ++bj)
#pragma unroll
            for (int n = 0; n < 2; ++n) bv[bj][n] = *(const f32x4*)(bias + col0 + bj * HALF + 4 * n);
#pragma unroll
        for (int ai = 0; ai < 2; ++ai)
#pragma unroll
            for (int m = 0; m < 4; ++m) {
                const size_t row = (size_t)(row0 + ai * HALF + m * 16);
#pragma unroll
                for (int bj = 0; bj < 2; ++bj) {
                    const int col = col0 + bj * HALF;
                    const u32x4 zw = *(const u32x4*)(Z + row * 1024 + col), gw = *(const u32x4*)(GS + row * 1024 + col);
                    const f32x4 a0 = acc[ai][bj][m][0] + bv[bj][0], a1 = acc[ai][bj][m][1] + bv[bj][1];
                    float o[8];
#pragma unroll
                    for (int e = 0; e < 8; ++e) {
                        const unsigned zz = zw[e >> 1], gg = gw[e >> 1];
                        const float zf = __builtin_bit_cast(float, (e & 1) ? (zz & 0xffff0000u) : (zz << 16));
                        const float gf = __builtin_bit_cast(float, (e & 1) ? (gg & 0xffff0000u) : (gg << 16));
                        const float a = e < 4 ? a0[e & 3] : a1[e & 3];
                        o[e] = zf * __builtin_amdgcn_rcpf(1.0f + __expf(-a)) * gf;
                    }
                    u32x4 w; w.x = cvt_pk_bf16(o[0], o[1]); w.y = cvt_pk_bf16(o[2], o[3]); w.z = cvt_pk_bf16(o[4], o[5]); w.w = cvt_pk_bf16(o[6], o[7]);
                    *(u32x4*)(BR + row * 2048 + 1024 + col) = w;
                }
            }
    }
};
struct EpiOut {
    static constexpr bool PERM = false, AFTER_DRAIN = false;
    const float* xp; const float* xs; const float* bias; float* yp; float* ys; float alpha;
    __device__ __forceinline__ void operator()(const f32x4 (&acc)[2][2][4][2], const Unit& u, int wr, int wc, int fr, int fq) const {
        const int row0 = u.pm * BM + wr * 64 + fr, col0 = u.pn * BM + wc * 32 + 4 * fq;
        f32x4 bv[2][2];
#pragma unroll
        for (int bj = 0; bj < 2; ++bj)
#pragma unroll
            for (int n = 0; n < 2; ++n) bv[bj][n] = *(const f32x4*)(bias + col0 + bj * HALF + n * 16);
#pragma unroll
        for (int ai = 0; ai < 2; ++ai)
#pragma unroll
            for (int m = 0; m < 4; ++m) {
                const int row = row0 + ai * HALF + m * 16;
                if (row < M_TOT) {
                    const float* xr = row < M_P ? xp + (size_t)row * DM : xs + (size_t)(row - M_P) * DM;
                    float* yr = row < M_P ? yp + (size_t)row * DM : ys + (size_t)(row - M_P) * DM;
#pragma unroll
                    for (int bj = 0; bj < 2; ++bj)
#pragma unroll
                        for (int n = 0; n < 2; ++n) { const int col = col0 + bj * HALF + n * 16;
                            const f32x4 xv = *(const f32x4*)(xr + col);
                            *(f32x4*)(yr + col) = acc[ai][bj][m][n] + bv[bj][n] + xv * alpha; }
                }
            }
    }
};
template <class Epi, class Sched, bool ALIGN_EPI = false, bool SP2 = false>
__device__ __forceinline__ void gemm_phase(PG8_LAS unsigned char* lds, const Gemm g, const Sched& S, const Epi& E) {
    const int tid = threadIdx.x, wid = __builtin_amdgcn_readfirstlane(tid >> 6), lane = tid & 63, wr = wid >> 2, wc = wid & 3, fr = lane & 15, fq = lane >> 4;
    const int K = g.K, nt = K / BK;
    unsigned voffA[2], voffB[2];
#pragma unroll
    for (int i = 0; i < 2; ++i) { int R, C; stage_rc(tid * 16 + i * 8192, R, C); const int Rb = Epi::PERM ? ((R & ~31) + perm32(R & 31)) : R;
        voffA[i] = (unsigned)(R * K + C) * 2u; voffB[i] = (unsigned)(Rb * K + C) * 2u; }
    const size_t kstep = (size_t)(BK * 2);
    const size_t hstep = (size_t)HALF * K * 2;
    const size_t tstep = 2 * hstep;
    const unsigned ldsw = (unsigned)wid * 1024u;
    const int aoff = lds_byte(wr * 64 + fr, fq * 8), boff = lds_byte(wc * 32 + fr, fq * 8);
#define PG8_SA(b, h) (((b) * 2 + (h)) * HTB)
#define PG8_SB(b, h) ((4 + (b) * 2 + (h)) * HTB)
#define PG8_STAGE(bufoff, gbase, voff) do { _Pragma("unroll") for (int _i = 0; _i < 2; ++_i) \
        __builtin_amdgcn_global_load_lds((const unsigned*)((const char*)(gbase) + (voff)[_i]), (PG8_LAS unsigned*)(lds + (bufoff) + ldsw + _i * 8192), 16, 0, 0); } while (0)
#define PG8_LDA(dst, b, h) do { _Pragma("unroll") for (int m = 0; m < 4; ++m) _Pragma("unroll") for (int k = 0; k < 2; ++k) dst[m][k] = *(const PG8_LAS bf16x8*)(lds + PG8_SA(b, h) + aoff + m * 2048 + k * 1024); } while (0)
#define PG8_LDB(dst, b, h) do { _Pragma("unroll") for (int n = 0; n < 2; ++n) _Pragma("unroll") for (int k = 0; k < 2; ++k) dst[n][k] = *(const PG8_LAS bf16x8*)(lds + PG8_SB(b, h) + boff + n * 2048 + k * 1024); } while (0)
#define PG8_MMA(ai, bj, At, Bt) do { __builtin_amdgcn_s_setprio(1); _Pragma("unroll") for (int m = 0; m < 4; ++m) _Pragma("unroll") for (int n = 0; n < 2; ++n) _Pragma("unroll") for (int k = 0; k < 2; ++k) \
        acc[ai][bj][m][n] = __builtin_amdgcn_mfma_f32_16x16x32_bf16(Bt[n][k], At[m][k], acc[ai][bj][m][n], 0, 0, 0); __builtin_amdgcn_s_setprio(0); } while (0)
#define PG8_WAIT_V(n) asm volatile("s_waitcnt vmcnt(" #n ")" ::: "memory")
#define PG8_WAIT_L(n) asm volatile("s_waitcnt lgkmcnt(" #n ")" ::: "memory")
#define PG8_BAR __builtin_amdgcn_s_barrier()
#define PG8_SCHED __builtin_amdgcn_sched_barrier(0)
    Unit cur, nxt; int ui = 0;
    if (!S.next(0, cur)) return;
    f32x4 acc[2][2][4][2];
#pragma unroll
    for (int a = 0; a < 2; ++a)
#pragma unroll
        for (int b = 0; b < 2; ++b)
#pragma unroll
            for (int m = 0; m < 4; ++m)
#pragma unroll
                for (int n = 0; n < 2; ++n) acc[a][b][m][n] = (f32x4){0.f, 0.f, 0.f, 0.f};
    bf16x8 At[4][2], B0[2][2], B1[2][2];
    const char* cA = (const char*)g.A + (size_t)cur.pm * tstep; const char* cB = (const char*)g.Bt + (size_t)cur.pn * tstep;
    S.a_ready(cur);
    if constexpr (SP2) {
        PG8_STAGE(PG8_SB(0, 0), cB, voffB); PG8_STAGE(PG8_SB(0, 1), cB + hstep, voffB); PG8_STAGE(PG8_SA(0, 0), cA, voffA); PG8_STAGE(PG8_SA(0, 1), cA + hstep, voffA);
        if (wr == 1) PG8_BAR;
        PG8_WAIT_V(2); PG8_BAR;
        PG8_STAGE(PG8_SB(1, 0), cB + kstep, voffB); PG8_STAGE(PG8_SA(1, 0), cA + kstep, voffA); PG8_STAGE(PG8_SB(1, 1), cB + hstep + kstep, voffB);
        PG8_WAIT_V(6); PG8_BAR;
    } else {
        PG8_STAGE(PG8_SB(0, 0), cB, voffB); PG8_STAGE(PG8_SA(0, 0), cA, voffA); PG8_STAGE(PG8_SB(0, 1), cB + hstep, voffB); PG8_STAGE(PG8_SA(0, 1), cA + hstep, voffA);
        if (wr == 1) PG8_BAR;
        PG8_WAIT_V(4); PG8_BAR;
        PG8_STAGE(PG8_SB(1, 0), cB + kstep, voffB); PG8_STAGE(PG8_SA(1, 0), cA + kstep, voffA); PG8_STAGE(PG8_SB(1, 1), cB + hstep + kstep, voffB);
        PG8_WAIT_V(6); PG8_BAR;
    }
    for (;;) {
        const bool has_next = S.next(ui + 1, nxt);
        const char* nA = has_next ? (const char*)g.A + (size_t)nxt.pm * tstep : cA; const char* nB = has_next ? (const char*)g.Bt + (size_t)nxt.pn * tstep : cB;
        for (int t = 0; t < nt; t += 2) {
            const bool last = (t == nt - 2);
            const char* a1 = cA + (size_t)(t + 1) * kstep;
            const char* a2 = last ? nA : cA + (size_t)(t + 2) * kstep; const char* b2 = last ? nB : cB + (size_t)(t + 2) * kstep;
            const char* a3 = a2 + kstep; const char* b3 = b2 + kstep;
            if (last && has_next) S.a_ready(nxt);
            if constexpr (SP2) {
            PG8_LDB(B0, 0, 0); PG8_LDB(B1, 0, 1); PG8_SCHED; PG8_LDA(At, 0, 0); PG8_STAGE(PG8_SA(1, 1), a1 + hstep, voffA);
            PG8_WAIT_V(8); PG8_WAIT_L(0); PG8_BAR; PG8_MMA(0, 0, At, B0); PG8_MMA(0, 1, At, B1); PG8_BAR; PG8_SCHED;
            PG8_LDA(At, 0, 1); PG8_STAGE(PG8_SB(0, 0), b2, voffB); PG8_STAGE(PG8_SB(0, 1), b2 + hstep, voffB); PG8_STAGE(PG8_SA(0, 0), a2, voffA);
            PG8_WAIT_V(8); PG8_WAIT_L(0); PG8_BAR; PG8_MMA(1, 0, At, B0); PG8_MMA(1, 1, At, B1); PG8_BAR; PG8_SCHED;
            PG8_LDB(B0, 1, 0); PG8_LDB(B1, 1, 1); PG8_SCHED; PG8_LDA(At, 1, 0); PG8_STAGE(PG8_SA(0, 1), a2 + hstep, voffA);
            PG8_WAIT_V(8); PG8_WAIT_L(0); PG8_BAR; PG8_MMA(0, 0, At, B0); PG8_MMA(0, 1, At, B1); PG8_BAR; PG8_SCHED;
            PG8_LDA(At, 1, 1); PG8_STAGE(PG8_SB(1, 0), b3, voffB); PG8_STAGE(PG8_SB(1, 1), b3 + hstep, voffB); PG8_STAGE(PG8_SA(1, 0), a3, voffA);
            PG8_WAIT_V(8); PG8_WAIT_L(0); PG8_BAR; PG8_MMA(1, 0, At, B0); PG8_MMA(1, 1, At, B1); PG8_BAR; PG8_SCHED;
            } else {
            PG8_LDB(B0, 0, 0); PG8_SCHED; PG8_LDA(At, 0, 0); PG8_STAGE(PG8_SA(1, 1), a1 + hstep, voffA);
            PG8_WAIT_L(8); PG8_BAR; PG8_WAIT_L(0); PG8_MMA(0, 0, At, B0); PG8_BAR; PG8_SCHED;
            PG8_LDB(B1, 0, 1); PG8_STAGE(PG8_SB(0, 0), b2, voffB);
            PG8_BAR; PG8_WAIT_L(0); PG8_MMA(0, 1, At, B1); PG8_BAR;
            PG8_LDA(At, 0, 1); PG8_STAGE(PG8_SA(0, 0), a2, voffA);
            PG8_BAR; PG8_WAIT_L(0); PG8_MMA(1, 0, At, B0); PG8_BAR; PG8_SCHED;
            PG8_STAGE(PG8_SB(0, 1), b2 + hstep, voffB);
            PG8_WAIT_V(6); PG8_BAR; PG8_MMA(1, 1, At, B1); PG8_BAR;
            PG8_LDB(B0, 1, 0); PG8_SCHED; PG8_LDA(At, 1, 0); PG8_STAGE(PG8_SA(0, 1), a2 + hstep, voffA);
            PG8_WAIT_L(8); PG8_BAR; PG8_WAIT_L(0); PG8_MMA(0, 0, At, B0); PG8_BAR; PG8_SCHED;
            PG8_LDB(B1, 1, 1); PG8_STAGE(PG8_SB(1, 0), b3, voffB);
            PG8_BAR; PG8_WAIT_L(0); PG8_MMA(0, 1, At, B1); PG8_BAR;
            PG8_LDA(At, 1, 1); PG8_STAGE(PG8_SA(1, 0), a3, voffA);
            PG8_BAR; PG8_WAIT_L(0); PG8_MMA(1, 0, At, B0); PG8_BAR; PG8_SCHED;
            PG8_STAGE(PG8_SB(1, 1), b3 + hstep, voffB);
            PG8_WAIT_V(6); PG8_BAR; PG8_MMA(1, 1, At, B1); PG8_BAR;
            }
        }
        if constexpr (ALIGN_EPI) { if (wr == 0) PG8_BAR; }
        if constexpr (!Epi::AFTER_DRAIN) { E(acc, cur, wr, wc, fr, fq); S.done(cur); }
        if (!has_next) break;
#pragma unroll
        for (int a = 0; a < 2; ++a)
#pragma unroll
            for (int b = 0; b < 2; ++b)
#pragma unroll
                for (int m = 0; m < 4; ++m)
#pragma unroll
                    for (int n = 0; n < 2; ++n) acc[a][b][m][n] = (f32x4){0.f, 0.f, 0.f, 0.f};
        cur = nxt; cA = nA; cB = nB; ++ui;
        if constexpr (ALIGN_EPI) { if (wr == 1) PG8_BAR; }
    }
    PG8_WAIT_V(0);
    if constexpr (!ALIGN_EPI) { if (wr == 0) PG8_BAR; }
    PG8_BAR;
    if constexpr (Epi::AFTER_DRAIN) { E.fused(acc, cur, wr, wc, fr, fq, lds, wid, lane); S.done(cur); }
#undef PG8_SA
#undef PG8_SB
#undef PG8_STAGE
#undef PG8_LDA
#undef PG8_LDB
#undef PG8_MMA
#undef PG8_WAIT_V
#undef PG8_WAIT_L
#undef PG8_BAR
#undef PG8_SCHED
}
}
#define GAS __attribute__((address_space(1)))
#define LAS __attribute__((address_space(3)))
typedef unsigned short bf16;
typedef unsigned v4u __attribute__((ext_vector_type(4)));
typedef float f32x4 __attribute__((ext_vector_type(4)));
typedef short bf16x8 __attribute__((ext_vector_type(8)));
typedef GAS unsigned gu32;
typedef GAS unsigned long long gu64;
#define RLX_AGENT __ATOMIC_RELAXED, __HIP_MEMORY_SCOPE_AGENT
#define LDS_WAIT() asm volatile("s_waitcnt lgkmcnt(0)" ::: "memory")
#define VM_WAIT() asm volatile("s_waitcnt vmcnt(0)" ::: "memory")
__device__ __forceinline__ unsigned long long rt() { return __builtin_amdgcn_s_memrealtime(); }
__device__ __forceinline__ unsigned f2bf(float f) { unsigned u = __builtin_bit_cast(unsigned, f); return (u + 0x7fffu + ((u >> 16) & 1u)) >> 16; }
__device__ __forceinline__ unsigned pk2(float lo, float hi) { return f2bf(lo) | (f2bf(hi) << 16); }

#define XB_TMO      128
#define XB_XCNT(j)  (256  + 64 * (j))
#define XB_XSUB(j)  (1280 + 64 * (j))
#define XB_XGEN(j)  (2304 + 64 * (j))
#define XB_TOP      3328
#define XB_TOPGEN   3392
#define XCD_BAR_WORDS 3456
#define XB_SPIN_CAP (1u << 18)

__device__ __forceinline__ unsigned xb_ld(unsigned* p)              { return __hip_atomic_load(p, __ATOMIC_RELAXED, __HIP_MEMORY_SCOPE_AGENT); }
__device__ __forceinline__ unsigned xb_add(unsigned* p, unsigned v) { return __hip_atomic_fetch_add(p, v, __ATOMIC_RELAXED, __HIP_MEMORY_SCOPE_AGENT); }
__device__ __forceinline__ unsigned xb_xcc_id() { return (unsigned)__builtin_amdgcn_s_getreg((3 << 11) | 20) & 0xFu; }
#define XB_SPIN(cond, bar) do { unsigned _sp = 0; while (cond) { __builtin_amdgcn_s_sleep(1); \
    if ((++_sp & 255u) == 0u) { if (xb_ld(&(bar)[XB_TMO])) break; if (_sp > XB_SPIN_CAP) { atomicAdd(&(bar)[XB_TMO], 1u); break; } } } } while (0)

struct XcdBarrier {
    unsigned* bar; unsigned x;
    volatile LAS unsigned* st;
};

__device__ __forceinline__ XcdBarrier xcd_barrier_post(unsigned* bar, volatile LAS unsigned* st) {
    XcdBarrier b; b.bar = bar; b.x = xb_xcc_id(); b.st = st;
    if (threadIdx.x == 0) (void)xb_add(&bar[XB_XCNT(b.x)], 1u);
    return b;
}
__device__ __forceinline__ void xcd_barrier_complete(unsigned* bar, unsigned x, unsigned& nloc, unsigned& nx) {
    const unsigned G = gridDim.x * gridDim.y * gridDim.z;
    unsigned sum, cnt, mine, sp = 0u;
    for (;;) {
        sum = 0u; cnt = 0u; mine = 0u;
#pragma unroll
        for (unsigned j = 0; j < 16; ++j) { const unsigned c = xb_ld(&bar[XB_XCNT(j)]); sum += c; cnt += (c > 0u) ? 1u : 0u; mine = (j == x) ? c : mine; }
        if (sum == G) break;
        __builtin_amdgcn_s_sleep(1);
        if ((++sp & 255u) == 0u) { if (xb_ld(&bar[XB_TMO])) break; if (sp > XB_SPIN_CAP) { atomicAdd(&bar[XB_TMO], 1u); break; } }
    }
    nloc = mine > 0u ? mine : 1u; nx = cnt > 0u ? cnt : 1u;
}

__device__ __forceinline__ void xcd_barrier(const XcdBarrier& b) {
    asm volatile("s_waitcnt vmcnt(0)" ::: "memory");
    __syncthreads();
    if (threadIdx.x == 0) {
        unsigned* bar = b.bar;
        __builtin_amdgcn_s_waitcnt(0);
        unsigned nloc = b.st[0], nx = b.st[1];
        if (nloc == 0u) { xcd_barrier_complete(bar, b.x, nloc, nx); b.st[0] = nloc; b.st[1] = nx; }
        const unsigned old = xb_add(&bar[XB_XSUB(b.x)], 1u);
        const unsigned gen = old / nloc;
        if (old + 1u == (gen + 1u) * nloc) {
            __builtin_amdgcn_fence(__ATOMIC_RELEASE, "agent");
            asm volatile("s_waitcnt vmcnt(0)" ::: "memory");
            const unsigned og = xb_add(&bar[XB_TOP], 1u);
            const unsigned tg = og / nx;
            if (og + 1u == (tg + 1u) * nx) xb_add(&bar[XB_TOPGEN], 1u);
            else XB_SPIN(xb_ld(&bar[XB_TOPGEN]) == tg, bar);
            __builtin_amdgcn_fence(__ATOMIC_ACQUIRE, "agent");
            xb_add(&bar[XB_XGEN(b.x)], 1u);
            asm volatile("s_waitcnt vmcnt(0)" ::: "memory");
        } else {
            XB_SPIN(xb_ld(&bar[XB_XGEN(b.x)]) == gen, bar);
            __builtin_amdgcn_fence(__ATOMIC_ACQUIRE, "agent");
            asm volatile("s_waitcnt vmcnt(0)" ::: "memory");
        }
    }
    __syncthreads();
}
__device__ __forceinline__ float bf2f(unsigned short h) { return __builtin_bit_cast(float, (unsigned)h << 16); }
using pg8::M_P; using pg8::M_S; using pg8::M_TOT; using pg8::MR; using pg8::DM; using pg8::NPROJ; using pg8::DA;
constexpr int NWAVES = 8;
constexpr int SEQ = 8192, NHEAD = 16, HD = 64, NGRP = 64, NST = 64, NCH = 16;
constexpr float LN_EPS = 1e-5f;
constexpr float DN_ALPHA = 1.189207115002721f;
constexpr size_t MiB = 1u << 20;
constexpr size_t WS_CTL = 0, CTL_ZERO_BYTES = 1 * MiB;
constexpr size_t WS_WIN = 2 * MiB;
constexpr size_t WS_WGLU = 26 * MiB;
constexpr size_t WS_WOUT = 28 * MiB;
constexpr size_t WS_SA = 36 * MiB;
constexpr size_t WS_BBAR = 37 * MiB;
constexpr size_t WS_XB = 64 * MiB;
constexpr size_t WS_H = 136 * MiB;
constexpr size_t WS_BR = 336 * MiB;
constexpr size_t WS_Z = 404 * MiB;
constexpr size_t WS_END = 440 * MiB;
constexpr size_t HREG = (size_t)MR * DA;
constexpr size_t O_YP = 0, O_YS = 33554432, O_KP = 33816576, O_VP = 38010880, O_SRP = 42205184, O_SIP = 42213376,
                 O_KS = 42221568, O_VS = 42352640, O_SRS = 42483712, O_SIS = 42614784, O_TOTAL = 42745856;
constexpr int CW_TMO = 0, CW_CODE = 1, CW_BAR = 4096, CW_Q = 16384;
constexpr int RING_OFF = 0, RING_BYTES = 131072;
constexpr int LDSCTL_OFF = 163328, MISC_OFF = LDSCTL_OFF + 320;
constexpr int LDS_BYTES = 163840;
struct Frame {
    LAS unsigned char* lds;
    volatile LAS unsigned* MISC;
    gu32* ctl;
    int tid, lane, wave;
    int vcu, G;
    const float* in[22]; float* out; unsigned char* ws;
};
__device__ __forceinline__ float wave_sum(float v) {
#pragma unroll
    for (int o = 1; o < 64; o <<= 1) v += __shfl_xor(v, o);
    return v;
}
__device__ __forceinline__ void p0_transpose_item(const float* W, int K, int N, bf16* WT, LAS float* scr, int item, int lane) {
    const int nblk = N / 32, kb = item / nblk, nb = item % nblk, k0 = 64 * kb, n0 = 32 * nb;
#pragma unroll 8
    for (int i = 0; i < 32; ++i) { const int kk = 2 * i + (lane >> 5); scr[kk * 33 + (lane & 31)] = W[(size_t)(k0 + kk) * N + n0 + (lane & 31)]; }
    LDS_WAIT(); asm volatile("" ::: "memory");
    const int c = lane & 7;
#pragma unroll
    for (int j = 0; j < 4; ++j) { const int n = (lane >> 3) + 8 * j; const LAS float* s = scr + (8 * c) * 33 + n;
        v4u o; o.x = pk2(s[0 * 33], s[1 * 33]); o.y = pk2(s[2 * 33], s[3 * 33]); o.z = pk2(s[4 * 33], s[5 * 33]); o.w = pk2(s[6 * 33], s[7 * 33]);
        *(GAS v4u*)(WT + (size_t)(n0 + n) * K + k0 + 8 * c) = o; }
    LDS_WAIT(); asm volatile("" ::: "memory");
}
__device__ __forceinline__ void sincos_d(double x, double& s, double& c) {
    const double TWO_PI = 6.283185307179586476925286766559;
    const double k = rint(x / TWO_PI);
    const double r = fma(-k, TWO_PI, x);
    const double y = r * 0.125, y2 = y * y;
    double sn = y * (1.0 - y2 / 6.0 * (1.0 - y2 / 20.0 * (1.0 - y2 / 42.0 * (1.0 - y2 / 72.0 * (1.0 - y2 / 110.0 * (1.0 - y2 / 156.0 * (1.0 - y2 / 210.0)))))));
    double cs = 1.0 - y2 / 2.0 * (1.0 - y2 / 12.0 * (1.0 - y2 / 30.0 * (1.0 - y2 / 56.0 * (1.0 - y2 / 90.0 * (1.0 - y2 / 132.0 * (1.0 - y2 / 182.0 * (1.0 - y2 / 240.0)))))));
#pragma unroll
    for (int i = 0; i < 3; ++i) { const double s2 = 2.0 * sn * cs, c2 = cs * cs - sn * sn; sn = s2; cs = c2; }
    s = sn; c = cs;
}
__device__ __forceinline__ void p0_prologue(Frame& F) {
    LAS float* scr = (LAS float*)(F.lds + RING_OFF + F.wave * 16384);
    const int gw = F.vcu * NWAVES + F.wave, NGW = F.G * NWAVES;
    constexpr int I_IN = (DM / 64) * (NPROJ / 32), I_GLU = (1024 / 64) * (1024 / 32), I_OUT = (DM / 64) * (DM / 32);
    constexpr int NITEMS = I_IN + I_GLU + I_OUT;
    for (int it = gw; it < NITEMS; it += NGW) {
        int r = it;
        if (r < I_IN) { p0_transpose_item(F.in[6], DM, NPROJ, (bf16*)(F.ws + WS_WIN), scr, r, F.lane); continue; } r -= I_IN;
        if (r < I_GLU) { p0_transpose_item(F.in[18], 1024, 1024, (bf16*)(F.ws + WS_WGLU), scr, r, F.lane); continue; } r -= I_GLU;
        p0_transpose_item(F.in[7], DM, DM, (bf16*)(F.ws + WS_WOUT), scr, r, F.lane);
    }
    bf16* XB = (bf16*)(F.ws + WS_XB);
    for (int m = gw; m < MR; m += NGW) {
        GAS unsigned long long* o8 = (GAS unsigned long long*)(XB + (size_t)m * DM) + F.lane;
        if (m < M_TOT) {
            const float* xrow = m < M_P ? F.in[0] + (size_t)m * DM : F.in[1] + (size_t)(m - M_P) * DM;
            const GAS f32x4* xr = (const GAS f32x4*)xrow + F.lane;
#pragma unroll
            for (int j = 0; j < 8; ++j) { const f32x4 v = xr[64 * j]; o8[64 * j] = (unsigned long long)pk2(v.x, v.y) | ((unsigned long long)pk2(v.z, v.w) << 32); }
        } else {
#pragma unroll
            for (int j = 0; j < 8; ++j) o8[64 * j] = 0ull;
        }
    }
    const int gt = F.vcu * (NWAVES * 64) + F.tid;
    if (gt < NGRP * NST) {
        const int g = gt >> 6;
        const double lr = fmin((double)F.in[10][gt], -1e-4), li = (double)F.in[11][gt];
        const double dt = exp((double)F.in[12][g]);
        const double mag = exp(lr * dt); double sn, cs; sincos_d(li * dt, sn, cs);
        double ar = mag * cs, ai = mag * sn;
        const double den = lr * lr + li * li, inv_re = lr / den, inv_im = -li / den;
        const double n_re = ar - 1.0, n_im = ai;
        const double cf_re = n_re * inv_re - n_im * inv_im, cf_im = n_re * inv_im + n_im * inv_re;
        float* SA = (float*)(F.ws + WS_SA) + (size_t)gt * 8;
        SA[0] = (float)ar; SA[1] = (float)ai;
        double pr = ar, pi = ai;
        for (int i = 0; i < 10; ++i) { const double t = pr * pr - pi * pi; pi = 2.0 * pr * pi; pr = t; if (i == 4) { SA[2] = (float)pr; SA[3] = (float)pi; } }
        SA[4] = (float)pr; SA[5] = (float)pi; SA[6] = 0.f; SA[7] = 0.f;
        float* BB = (float*)(F.ws + WS_BBAR) + (size_t)gt * 32;
        const float* br = F.in[13] + (size_t)gt * 16; const float* bi = F.in[14] + (size_t)gt * 16;
        for (int c = 0; c < 16; ++c) { const double x = br[c], y = bi[c]; BB[2 * c] = (float)(cf_re * x - cf_im * y); BB[2 * c + 1] = (float)(cf_re * y + cf_im * x); }
    }
}
__device__ __forceinline__ int t5_bucket(int dist) {
    if (dist < 16) return dist;
    const float v = logf((float)dist / 16.0f) / 4.852030263919617f * 16.0f;
    const int large = 16 + (int)v;
    return large < 31 ? large : 31;
}
__device__ __forceinline__ float gelu_tanh(float y) {
    const float a = 0.7978845608028654f * (y + 0.044715f * y * y * y);
    const float t = __expf(2.0f * a);
    return 0.5f * y * (2.0f - 2.0f * __builtin_amdgcn_rcpf(t + 1.0f));
}
template <bool SAMPLE>
__device__ __forceinline__ void attn_simple_task(Frame& F, int task, const LAS int* bkt) {
    const int h = task & 15, rowi = task >> 4;
    const bf16* Hq = (const bf16*)(F.ws + WS_H);
    const size_t qrow = SAMPLE ? (size_t)(M_P + rowi) : (size_t)rowi;
    const int b = SAMPLE ? (rowi >> 2) : (rowi >> 13), t = SAMPLE ? (2048 + (rowi & 3)) : (rowi & 8191);
    unsigned qp[32];
    { const v4u* qv = (const v4u*)(Hq + qrow * DA + h * HD);
#pragma unroll
      for (int i = 0; i < 8; ++i) { const v4u w = qv[i]; qp[4 * i] = w.x; qp[4 * i + 1] = w.y; qp[4 * i + 2] = w.z; qp[4 * i + 3] = w.w; } }
    const bf16* Kb = Hq + HREG; const bf16* Vb = Hq + 2 * HREG;
    const float* ck = F.in[2]; const float* cv = F.in[3]; const float* kn = F.out + O_KS; const float* vn = F.out + O_VS;
    LAS float* lgs = (LAS float*)(F.lds + RING_OFF + 4096 + F.wave * 2048);
    float mx = -INFINITY;
#pragma unroll 1
    for (int i = 0; i < 7; ++i) {
        const int e = F.lane + 64 * i; float v = -INFINITY;
        if (e < 387) {
            const int p = e / 129, j = e - p * 129, d = p == 0 ? 1 : (p == 1 ? 4 : 16), kt = t - j * d;
            if (kt >= 0) {
                float dot = 0.f;
                if (SAMPLE) {
                    const float* kr = kt < 2048 ? ck + (((size_t)b * 2048 + kt) * NHEAD + h) * HD : kn + ((size_t)(b * 4 + kt - 2048)) * DA + h * HD;
#pragma unroll
                    for (int c = 0; c < 16; ++c) { const f32x4 kv = *(const f32x4*)(kr + 4 * c); const unsigned q0 = qp[2 * c], q1 = qp[2 * c + 1];
                        dot += __builtin_bit_cast(float, q0 << 16) * kv.x + __builtin_bit_cast(float, q0 & 0xffff0000u) * kv.y + __builtin_bit_cast(float, q1 << 16) * kv.z + __builtin_bit_cast(float, q1 & 0xffff0000u) * kv.w; }
                } else {
                    const v4u* kr = (const v4u*)(Kb + ((size_t)b * SEQ + kt) * DA + h * HD);
#pragma unroll
                    for (int c = 0; c < 8; ++c) { const v4u kw = kr[c];
#pragma unroll
                        for (int x = 0; x < 4; ++x) { const unsigned kk = kw[x], qq = qp[4 * c + x];
                            dot += __builtin_bit_cast(float, qq << 16) * __builtin_bit_cast(float, kk << 16) + __builtin_bit_cast(float, qq & 0xffff0000u) * __builtin_bit_cast(float, kk & 0xffff0000u); } }
                }
                v = dot + F.in[9][bkt[e] * NHEAD + h] * 1.4426950408889634f;
            }
            lgs[e] = v;
        }
        mx = fmaxf(mx, v);
    }
#pragma unroll
    for (int o = 1; o < 64; o <<= 1) mx = fmaxf(mx, __shfl_xor(mx, o));
    float sum = 0.f;
#pragma unroll 1
    for (int i = 0; i < 7; ++i) { const int e = F.lane + 64 * i; if (e < 387) { const float pr = exp2f(lgs[e] - mx); lgs[e] = pr; sum += pr; } }
    sum = wave_sum(sum);
    LDS_WAIT(); asm volatile("" ::: "memory");
    float acc = 0.f;
#pragma unroll 1
    for (int p = 0; p < 3; ++p) {
        const int d = p == 0 ? 1 : (p == 1 ? 4 : 16);
#pragma unroll 4
        for (int j = 0; j < 129; ++j) {
            const int kt = t - j * d;
            if (kt < 0) break;
            const float pe = lgs[p * 129 + j];
            float vv;
            if (SAMPLE) vv = kt < 2048 ? cv[(((size_t)b * 2048 + kt) * NHEAD + h) * HD + F.lane] : vn[((size_t)(b * 4 + kt - 2048)) * DA + h * HD + F.lane];
            else vv = bf2f(Vb[((size_t)b * SEQ + kt) * DA + h * HD + F.lane]);
            acc += pe * vv;
        }
    }
    LDS_WAIT(); asm volatile("" ::: "memory");
    const float ga = bf2f(Hq[3 * HREG + qrow * DA + h * HD + F.lane]);
    ((bf16*)(F.ws + WS_BR))[qrow * 2048 + h * HD + F.lane] = (bf16)f2bf(acc / sum * ga);
}
__device__ __forceinline__ void ssm_seq(Frame& F, int g, size_t rowbase, int L, const float* x0r, const float* x0i, float* outr, float* outi) {
    const int n = F.lane;
    const float* SA = (const float*)(F.ws + WS_SA) + (size_t)(g * NST + n) * 8;
    const float ar = SA[0], ai = SA[1];
    const float* BB = (const float*)(F.ws + WS_BBAR) + (size_t)(g * NST + n) * 32;
    float bbr[16], bbi[16], cre[16], cim[16];
#pragma unroll
    for (int c = 0; c < 16; ++c) { bbr[c] = BB[2 * c]; bbi[c] = BB[2 * c + 1]; cre[c] = F.in[15][(size_t)(g * NCH + c) * NST + n]; cim[c] = F.in[16][(size_t)(g * NCH + c) * NST + n]; }
    const float dsk = F.in[17][g * NCH + (n & 15)];
    float xr = x0r ? x0r[n] : 0.f, xi = x0i ? x0i[n] : 0.f;
    const bf16* U = (const bf16*)(F.ws + WS_H) + 4 * HREG; bf16* Z = (bf16*)(F.ws + WS_Z);
    for (int t = 0; t < L; ++t) {
        const size_t row = rowbase + t;
        const v4u* up = (const v4u*)(U + row * DA + g * NCH);
        const v4u u0 = up[0], u1 = up[1];
        float u[16];
#pragma unroll
        for (int c = 0; c < 4; ++c) { u[2 * c] = __builtin_bit_cast(float, u0[c] << 16); u[2 * c + 1] = __builtin_bit_cast(float, u0[c] & 0xffff0000u); u[8 + 2 * c] = __builtin_bit_cast(float, u1[c] << 16); u[9 + 2 * c] = __builtin_bit_cast(float, u1[c] & 0xffff0000u); }
        float bur = 0.f, bui = 0.f;
#pragma unroll
        for (int c = 0; c < 16; ++c) { bur += bbr[c] * u[c]; bui += bbi[c] * u[c]; }
        const float nxr = ar * xr - ai * xi + bur, nxi = ar * xi + ai * xr + bui;
        xr = nxr; xi = nxi;
        float yv = 0.f, uv = 0.f;
#pragma unroll
        for (int c = 0; c < 16; ++c) { const float s = wave_sum(cre[c] * xr - cim[c] * xi); if ((n & 15) == c) { yv = s; uv = u[c]; } }
        yv += dsk * uv;
        if (n < 16) Z[row * DA + g * NCH + n] = (bf16)f2bf(gelu_tanh(yv));
    }
    outr[n] = xr; outi[n] = xi;
}
__device__ __forceinline__ void ln_row_inplace(Frame& F, float* row) {
    GAS f32x4* xr = (GAS f32x4*)row + F.lane;
    f32x4 v[8]; float s = 0.f;
#pragma unroll
    for (int j = 0; j < 8; ++j) { v[j] = xr[64 * j]; s += (v[j].x + v[j].y) + (v[j].z + v[j].w); }
    const float mean = wave_sum(s) * (1.f / DM); float s2 = 0.f;
#pragma unroll
    for (int j = 0; j < 8; ++j) { v[j] = v[j] - mean; s2 += (v[j].x * v[j].x + v[j].y * v[j].y) + (v[j].z * v[j].z + v[j].w * v[j].w); }
    const float rstd = 1.f / sqrtf(wave_sum(s2) * (1.f / DM) + LN_EPS);
    const GAS f32x4* gp = (const GAS f32x4*)F.in[20] + F.lane; const GAS f32x4* bp = (const GAS f32x4*)F.in[21] + F.lane;
#pragma unroll
    for (int j = 0; j < 8; ++j) xr[64 * j] = v[j] * rstd * gp[64 * j] + bp[64 * j];
}
typedef float f32x16 __attribute__((ext_vector_type(16)));
typedef __bf16 bf16x2_t __attribute__((ext_vector_type(2)));
typedef float f32x2_t __attribute__((ext_vector_type(2)));
__device__ __forceinline__ unsigned cvtpk(float lo, float hi) { f32x2_t v = {lo, hi}; bf16x2_t b = __builtin_convertvector(v, bf16x2_t); return __builtin_bit_cast(unsigned, b); }
__device__ __forceinline__ bf16x8 pack8(float a0, float a1, float a2, float a3, float a4, float a5, float a6, float a7) {
    v4u w; w.x = cvtpk(a0, a1); w.y = cvtpk(a2, a3); w.z = cvtpk(a4, a5); w.w = cvtpk(a6, a7); return __builtin_bit_cast(bf16x8, w); }
constexpr int SSM_EP = 257;
constexpr int SSM_ST_OFF = 2 * 64 * SSM_EP * 4, SSM_A2T_OFF = SSM_ST_OFF + 4096, SSM_A1T_OFF = SSM_A2T_OFF + 8192, SSM_LDS_END = SSM_A1T_OFF + 5120;
__device__ __forceinline__ void ssm_fast_block(Frame& F, int b, int g) {
    const int lane = F.lane, w = F.wave, col = lane & 31, h = lane >> 5;
    LAS float* Ere = (LAS float*)(F.lds + RING_OFF); LAS float* Eim = Ere + 64 * SSM_EP;
    LAS float* ST = (LAS float*)(F.lds + RING_OFF + SSM_ST_OFF);
    LAS v4u* A2T = (LAS v4u*)(F.lds + RING_OFF + SSM_A2T_OFF);
    LAS v4u* A1T = (LAS v4u*)(F.lds + RING_OFF + SSM_A1T_OFF);
    const float* SA = (const float*)(F.ws + WS_SA) + (size_t)g * NST * 8;
    const float* BB = (const float*)(F.ws + WS_BBAR) + (size_t)g * NST * 32;
    const float* Cre = F.in[15] + (size_t)g * NCH * NST; const float* Cim = F.in[16] + (size_t)g * NCH * NST;
    float ar[2][16], ai[2][16];
#pragma unroll
    for (int s = 0; s < 2; ++s)
#pragma unroll
        for (int r = 0; r < 16; ++r) { const int n = 32 * s + (r & 3) + 8 * (r >> 2) + 4 * h; ar[s][r] = SA[n * 8]; ai[s][r] = SA[n * 8 + 1]; }
    if (w < 4) { const int tau = w; const int n = 32 * (tau >> 1) + col; float v[8];
#pragma unroll
        for (int jj = 0; jj < 8; ++jj) { const int ch = 4 * h + (jj & 3) + 8 * (jj >> 2); v[jj] = BB[n * 32 + 2 * ch + (tau & 1)]; }
        A1T[tau * 64 + lane] = __builtin_bit_cast(v4u, pack8(v[0], v[1], v[2], v[3], v[4], v[5], v[6], v[7])); }
    if (w == 4) { float v[8];
#pragma unroll
      for (int jj = 0; jj < 8; ++jj) { const int ch = 4 * h + (jj & 3) + 8 * (jj >> 2); v[jj] = (col < 16 && ch == col) ? F.in[17][g * NCH + col] : 0.f; }
      A1T[4 * 64 + lane] = __builtin_bit_cast(v4u, pack8(v[0], v[1], v[2], v[3], v[4], v[5], v[6], v[7])); }
    { const int tau = w >> 1, s = w & 1; float v[8];
#pragma unroll
      for (int jj = 0; jj < 8; ++jj) { const int n = 32 * (tau >> 1) + 16 * s + 8 * (jj >> 2) + 4 * h + (jj & 3);
          v[jj] = col < 16 ? ((tau & 1) ? -Cim[col * NST + n] : Cre[col * NST + n]) : 0.f; }
      A2T[w * 64 + lane] = __builtin_bit_cast(v4u, pack8(v[0], v[1], v[2], v[3], v[4], v[5], v[6], v[7])); }
    __syncthreads();
#define A1F(k) __builtin_bit_cast(bf16x8, A1T[(k) * 64 + lane])
    const size_t row0 = (size_t)b * SEQ + 32 * (32 * w + col);
    const bf16* Up = (const bf16*)(F.ws + WS_H) + 4 * HREG + row0 * DA + g * NCH + 4 * h;
    bf16* Zp = (bf16*)(F.ws + WS_Z) + row0 * DA + g * NCH + 4 * h;
    typedef unsigned long long u64x2 __attribute__((ext_vector_type(2)));
#define SSM_LOADU(t) ({ u64x2 _q; _q.x = *(const GAS unsigned long long*)(Up + (size_t)(t) * DA); _q.y = *(const GAS unsigned long long*)(Up + (size_t)(t) * DA + 8); __builtin_bit_cast(bf16x8, _q); })
    float xr[2][16], xi[2][16];
#pragma unroll
    for (int s = 0; s < 2; ++s)
#pragma unroll
        for (int r = 0; r < 16; ++r) { xr[s][r] = 0.f; xi[s][r] = 0.f; }
    const f32x16 zero16 = {0.f, 0.f, 0.f, 0.f, 0.f, 0.f, 0.f, 0.f, 0.f, 0.f, 0.f, 0.f, 0.f, 0.f, 0.f, 0.f};
    {
        bf16x8 B1 = SSM_LOADU(0);
#pragma unroll 1
        for (int t = 0; t < 32; ++t) {
            asm volatile("" ::: "memory");
            const bf16x8 Bn = SSM_LOADU(t < 31 ? t + 1 : 31);
#pragma unroll
            for (int s = 0; s < 2; ++s) {
                const f32x16 bre = __builtin_amdgcn_mfma_f32_32x32x16_bf16(A1F(2 * s), B1, zero16, 0, 0, 0);
                const f32x16 bim = __builtin_amdgcn_mfma_f32_32x32x16_bf16(A1F(2 * s + 1), B1, zero16, 0, 0, 0);
#pragma unroll
                for (int r = 0; r < 16; ++r) { const float nr = ar[s][r] * xr[s][r] - ai[s][r] * xi[s][r] + bre[r], ni = ar[s][r] * xi[s][r] + ai[s][r] * xr[s][r] + bim[r]; xr[s][r] = nr; xi[s][r] = ni; }
            }
            B1 = Bn;
        }
    }
    { const int c = 32 * w + col;
#pragma unroll
      for (int s = 0; s < 2; ++s)
#pragma unroll
          for (int r = 0; r < 16; ++r) { const int n = 32 * s + (r & 3) + 8 * (r >> 2) + 4 * h; Ere[n * SSM_EP + c] = xr[s][r]; Eim[n * SSM_EP + c] = xi[s][r]; } }
    __syncthreads();
    {
        const int n = lane; const float a32r = SA[n * 8 + 2], a32i = SA[n * 8 + 3], a1kr = SA[n * 8 + 4], a1ki = SA[n * 8 + 5];
        float cr = 0.f, ci = 0.f;
#pragma unroll 4
        for (int k = 0; k < 32; ++k) { const int idx = n * SSM_EP + 32 * w + k; const float tr = Ere[idx], ti = Eim[idx]; Ere[idx] = cr; Eim[idx] = ci;
            const float nr = a32r * cr - a32i * ci + tr, ni = a32r * ci + a32i * cr + ti; cr = nr; ci = ni; }
        ST[(w * 64 + n) * 2] = cr; ST[(w * 64 + n) * 2 + 1] = ci;
        __syncthreads();
        float pr = 0.f, pi = 0.f;
        for (int w2 = 0; w2 < w; ++w2) { const float tr = ST[(w2 * 64 + n) * 2], ti = ST[(w2 * 64 + n) * 2 + 1]; const float nr = a1kr * pr - a1ki * pi + tr, ni = a1kr * pi + a1ki * pr + ti; pr = nr; pi = ni; }
#pragma unroll 4
        for (int k = 0; k < 32; ++k) { const int idx = n * SSM_EP + 32 * w + k; Ere[idx] += pr; Eim[idx] += pi; const float nr = a32r * pr - a32i * pi, ni = a32r * pi + a32i * pr; pr = nr; pi = ni; }
    }
    __syncthreads();
    { const int c = 32 * w + col;
#pragma unroll
      for (int s = 0; s < 2; ++s)
#pragma unroll
          for (int r = 0; r < 16; ++r) { const int n = 32 * s + (r & 3) + 8 * (r >> 2) + 4 * h; xr[s][r] = Ere[n * SSM_EP + c]; xi[s][r] = Eim[n * SSM_EP + c]; } }
    {
        bf16x8 B1 = SSM_LOADU(0);
#pragma unroll 1
        for (int t = 0; t < 32; ++t) {
            asm volatile("" ::: "memory");
            const bf16x8 Bn = SSM_LOADU(t < 31 ? t + 1 : 31);
            f32x16 Y = __builtin_amdgcn_mfma_f32_32x32x16_bf16(A1F(4), B1, zero16, 0, 0, 0);
#pragma unroll
            for (int s = 0; s < 2; ++s) {
                const f32x16 bre = __builtin_amdgcn_mfma_f32_32x32x16_bf16(A1F(2 * s), B1, zero16, 0, 0, 0);
                const f32x16 bim = __builtin_amdgcn_mfma_f32_32x32x16_bf16(A1F(2 * s + 1), B1, zero16, 0, 0, 0);
#pragma unroll
                for (int r = 0; r < 16; ++r) { const float nr = ar[s][r] * xr[s][r] - ai[s][r] * xi[s][r] + bre[r], ni = ar[s][r] * xi[s][r] + ai[s][r] * xr[s][r] + bim[r]; xr[s][r] = nr; xi[s][r] = ni; }
#pragma unroll
                for (int q = 0; q < 2; ++q) {
                    const bf16x8 fre = pack8(xr[s][8 * q], xr[s][8 * q + 1], xr[s][8 * q + 2], xr[s][8 * q + 3], xr[s][8 * q + 4], xr[s][8 * q + 5], xr[s][8 * q + 6], xr[s][8 * q + 7]);
                    const bf16x8 fim = pack8(xi[s][8 * q], xi[s][8 * q + 1], xi[s][8 * q + 2], xi[s][8 * q + 3], xi[s][8 * q + 4], xi[s][8 * q + 5], xi[s][8 * q + 6], xi[s][8 * q + 7]);
                    const bf16x8 are = __builtin_bit_cast(bf16x8, A2T[(4 * s + q) * 64 + lane]);
                    const bf16x8 aim = __builtin_bit_cast(bf16x8, A2T[(4 * s + 2 + q) * 64 + lane]);
                    Y = __builtin_amdgcn_mfma_f32_32x32x16_bf16(are, fre, Y, 0, 0, 0);
                    Y = __builtin_amdgcn_mfma_f32_32x32x16_bf16(aim, fim, Y, 0, 0, 0);
                }
            }
            const unsigned long long z0 = (unsigned long long)cvtpk(gelu_tanh(Y[0]), gelu_tanh(Y[1])) | ((unsigned long long)cvtpk(gelu_tanh(Y[2]), gelu_tanh(Y[3])) << 32);
            const unsigned long long z1 = (unsigned long long)cvtpk(gelu_tanh(Y[4]), gelu_tanh(Y[5])) | ((unsigned long long)cvtpk(gelu_tanh(Y[6]), gelu_tanh(Y[7])) << 32);
            *(GAS unsigned long long*)(Zp + (size_t)t * DA) = z0; *(GAS unsigned long long*)(Zp + (size_t)t * DA + 8) = z1;
            B1 = Bn;
        }
    }
#undef SSM_LOADU
#undef A1F
    if (w == 7 && col == 31) {
        float* outr = F.out + O_SRP + (size_t)(b * NGRP + g) * NST; float* outi = F.out + O_SIP + (size_t)(b * NGRP + g) * NST;
#pragma unroll
        for (int s = 0; s < 2; ++s)
#pragma unroll
            for (int r = 0; r < 16; ++r) { const int n = 32 * s + (r & 3) + 8 * (r >> 2) + 4 * h; outr[n] = xr[s][r]; outi[n] = xi[s][r]; }
    }
    __syncthreads();
}
typedef short v4i16_t __attribute__((ext_vector_type(4)));
constexpr int AT_OST = 0, AT_ML = 65536, AT_TB = 69632, AT_VST = 73728, AT_LDS_END = AT_VST + 8 * 4096;
__device__ __forceinline__ float xhalf_max(float v) { auto rr = __builtin_amdgcn_permlane32_swap(__float_as_uint(v), __float_as_uint(v), false, false); return fmaxf(__uint_as_float(rr[0]), __uint_as_float(rr[1])); }
__device__ __forceinline__ float xhalf_sum(float v) { auto rr = __builtin_amdgcn_permlane32_swap(__float_as_uint(v), __float_as_uint(v), false, false); return __uint_as_float(rr[0]) + __uint_as_float(rr[1]); }
__device__ __forceinline__ void attn_fast_unit(Frame& F, int b, int h, int wi) {
    const int lane = F.lane, w = F.wave, qi = lane & 31, hh = lane >> 5;
    LAS unsigned long long* OST = (LAS unsigned long long*)(F.lds + RING_OFF + AT_OST);
    LAS float* ML = (LAS float*)(F.lds + RING_OFF + AT_ML);
    LAS float* TB = (LAS float*)(F.lds + RING_OFF + AT_TB);
    LAS unsigned char* VST = F.lds + RING_OFF + AT_VST + w * 4096;
    for (int e = F.tid; e < 3 * 192; e += NWAVES * 64) { const int p = e / 192, y = e - p * 192, rel = 159 - y;
        TB[e] = (rel >= 0 && rel <= 128) ? F.in[9][t5_bucket(rel << (2 * p)) * NHEAD + h] * 1.4426950408889634f : -1e30f; }
    __syncthreads();
    const bf16* Hb = (const bf16*)(F.ws + WS_H);
    const bf16* Qb = Hb + h * HD; const bf16* Kb = Hb + HREG + h * HD; const bf16* Vb = Hb + 2 * HREG + h * HD; const bf16* Gb = Hb + 3 * HREG + h * HD;
    bf16* BR = (bf16*)(F.ws + WS_BR) + h * HD;
    const size_t rowbase = (size_t)b * SEQ; const int P0 = 512 * wi;
    int vkey[4], vdst[4], vcol[4];
#pragma unroll
    for (int i = 0; i < 4; ++i) { const int cid = lane + 64 * i, key = cid >> 3, c8 = cid & 7; vkey[i] = key; vcol[i] = 8 * c8; vdst[i] = ((key >> 3) * 2 + (c8 >> 2)) * 512 + (key & 7) * 64 + (c8 & 3) * 16; }
    const int trb = (4 * hh + ((lane >> 2) & 3)) * 64 + (16 * ((lane >> 4) & 1) + 4 * (lane & 3)) * 2;
#pragma unroll 1
    for (int p = 0; p < 3; ++p) {
        const int sh = 2 * p, d = 1 << sh, nsh = 4 - sh;
        const LAS float* TBp = TB + p * 192;
#pragma unroll 1
        for (int qq = 0; qq < 2; ++qq) {
            const int qt = 2 * w + qq, r = qt >> nsh, ti = qt & ((1 << nsh) - 1);
            const int qloc = r + d * (32 * ti + qi), slot = qloc ^ ((qloc >> 5) & 15);
            const size_t pq = rowbase + P0 + qloc;
            bf16x8 qf[4];
#pragma unroll
            for (int ks = 0; ks < 4; ++ks) qf[ks] = *(const bf16x8*)(Qb + pq * DA + 16 * ks + 8 * hh);
            f32x16 O0, O1; float m, l;
            if (p == 0) {
#pragma unroll
                for (int r2 = 0; r2 < 16; ++r2) { O0[r2] = 0.f; O1[r2] = 0.f; }
                m = -1e30f; l = 0.f;
            } else {
#pragma unroll
                for (int k = 0; k < 4; ++k) {
                    const unsigned long long a = OST[(2 * k + hh) * 512 + slot], c = OST[(8 + 2 * k + hh) * 512 + slot];
                    O0[4 * k] = __builtin_bit_cast(float, (unsigned)a << 16); O0[4 * k + 1] = __builtin_bit_cast(float, (unsigned)a & 0xffff0000u);
                    O0[4 * k + 2] = __builtin_bit_cast(float, (unsigned)(a >> 32) << 16); O0[4 * k + 3] = __builtin_bit_cast(float, (unsigned)(a >> 32) & 0xffff0000u);
                    O1[4 * k] = __builtin_bit_cast(float, (unsigned)c << 16); O1[4 * k + 1] = __builtin_bit_cast(float, (unsigned)c & 0xffff0000u);
                    O1[4 * k + 2] = __builtin_bit_cast(float, (unsigned)(c >> 32) << 16); O1[4 * k + 3] = __builtin_bit_cast(float, (unsigned)(c >> 32) & 0xffff0000u);
                }
                m = ML[slot * 2]; l = hh == 0 ? ML[slot * 2 + 1] : 0.f;
            }
#pragma unroll 1
            for (int tp = 0; tp < 5; ++tp) {
                const int mk0 = (P0 >> sh) + 32 * (ti - tp);
                if (mk0 < 0) continue;
                const size_t kbase = rowbase + r + ((size_t)mk0 << sh);
                bf16x8 kf[4];
                { const bf16* kp = Kb + (kbase + ((size_t)qi << sh)) * DA + 8 * hh;
#pragma unroll
                  for (int ks = 0; ks < 4; ++ks) kf[ks] = *(const bf16x8*)(kp + 16 * ks); }
                v4u vr[4];
#pragma unroll
                for (int i = 0; i < 4; ++i) vr[i] = *(const v4u*)(Vb + (kbase + ((size_t)vkey[i] << sh)) * DA + vcol[i]);
                f32x16 S;
                { const LAS float* tb = TBp + (159 - 32 * tp - qi + 4 * hh);
#pragma unroll
                  for (int r2 = 0; r2 < 16; ++r2) S[r2] = tb[(r2 & 3) + 8 * (r2 >> 2)]; }
#pragma unroll
                for (int ks = 0; ks < 4; ++ks) S = __builtin_amdgcn_mfma_f32_32x32x16_bf16(kf[ks], qf[ks], S, 0, 0, 0);
#pragma unroll
                for (int i = 0; i < 4; ++i) *(LAS v4u*)(VST + vdst[i]) = vr[i];
                float mx = fmaxf(fmaxf(S[0], S[1]), fmaxf(S[2], S[3]));
#pragma unroll
                for (int r2 = 4; r2 < 16; r2 += 4) mx = fmaxf(mx, fmaxf(fmaxf(S[r2], S[r2 + 1]), fmaxf(S[r2 + 2], S[r2 + 3])));
                mx = xhalf_max(mx);
                const float mn = fmaxf(m, mx), alpha = exp2f(m - mn);
                m = mn;
                float ps = 0.f;
#pragma unroll
                for (int r2 = 0; r2 < 16; ++r2) { S[r2] = exp2f(S[r2] - mn); ps += S[r2]; }
                l = l * alpha + ps;
#pragma unroll
                for (int r2 = 0; r2 < 16; ++r2) { O0[r2] *= alpha; O1[r2] *= alpha; }
                const bf16x8 pf0 = pack8(S[0], S[1], S[2], S[3], S[4], S[5], S[6], S[7]);
                const bf16x8 pf1 = pack8(S[8], S[9], S[10], S[11], S[12], S[13], S[14], S[15]);
#define AT_VTR(off) __builtin_bit_cast(v4i16_t, __builtin_amdgcn_ds_read_tr16_b64_v4i16((LAS v4i16_t*)(VST + trb + (off))))
#define AT_VT(s2, dt) ({ const v4i16_t _a = AT_VTR((4 * (s2) + (dt)) * 512), _b = AT_VTR((4 * (s2) + 2 + (dt)) * 512); (bf16x8){_a[0], _a[1], _a[2], _a[3], _b[0], _b[1], _b[2], _b[3]}; })
                { const bf16x8 v00 = AT_VT(0, 0), v10 = AT_VT(1, 0), v01 = AT_VT(0, 1), v11 = AT_VT(1, 1);
                  O0 = __builtin_amdgcn_mfma_f32_32x32x16_bf16(v00, pf0, O0, 0, 0, 0); O0 = __builtin_amdgcn_mfma_f32_32x32x16_bf16(v10, pf1, O0, 0, 0, 0);
                  O1 = __builtin_amdgcn_mfma_f32_32x32x16_bf16(v01, pf0, O1, 0, 0, 0); O1 = __builtin_amdgcn_mfma_f32_32x32x16_bf16(v11, pf1, O1, 0, 0, 0); }
#undef AT_VT
#undef AT_VTR
            }
            const float lt = xhalf_sum(l);
            if (p < 2) {
#pragma unroll
                for (int k = 0; k < 4; ++k) {
                    OST[(2 * k + hh) * 512 + slot] = (unsigned long long)cvtpk(O0[4 * k], O0[4 * k + 1]) | ((unsigned long long)cvtpk(O0[4 * k + 2], O0[4 * k + 3]) << 32);
                    OST[(8 + 2 * k + hh) * 512 + slot] = (unsigned long long)cvtpk(O1[4 * k], O1[4 * k + 1]) | ((unsigned long long)cvtpk(O1[4 * k + 2], O1[4 * k + 3]) << 32);
                }
                if (hh == 0) { ML[slot * 2] = m; ML[slot * 2 + 1] = lt; }
            } else {
                const float inv = 1.0f / lt;
#pragma unroll
                for (int k = 0; k < 4; ++k) {
#pragma unroll
                    for (int dt = 0; dt < 2; ++dt) {
                        const size_t off = pq * DA + 32 * dt + 8 * k + 4 * hh;
                        const unsigned long long gw = *(const GAS unsigned long long*)(Gb + off);
                        const float g0 = __builtin_bit_cast(float, (unsigned)gw << 16), g1 = __builtin_bit_cast(float, (unsigned)gw & 0xffff0000u);
                        const float g2 = __builtin_bit_cast(float, (unsigned)(gw >> 32) << 16), g3 = __builtin_bit_cast(float, (unsigned)(gw >> 32) & 0xffff0000u);
                        const float o0 = (dt ? O1[4 * k] : O0[4 * k]) * inv * g0, o1 = (dt ? O1[4 * k + 1] : O0[4 * k + 1]) * inv * g1;
                        const float o2 = (dt ? O1[4 * k + 2] : O0[4 * k + 2]) * inv * g2, o3 = (dt ? O1[4 * k + 3] : O0[4 * k + 3]) * inv * g3;
                        *(GAS unsigned long long*)(BR + pq * 2048 + 32 * dt + 8 * k + 4 * hh) = (unsigned long long)cvtpk(o0, o1) | ((unsigned long long)cvtpk(o2, o3) << 32);
                    }
                }
            }
        }
        __syncthreads();
    }
}
#ifndef MK_N_LAUNCHES
#define MK_N_LAUNCHES 1
#endif
constexpr int N_PHASES = 6;
constexpr int N_LAUNCHES = MK_N_LAUNCHES;
struct Args { const float* in[22]; float* out; unsigned char* ws; int ph_lo, ph_hi, li, pad; };
__global__ void __launch_bounds__(NWAVES * 64, 2) fwd_kernel(Args args) {
    extern __shared__ __attribute__((aligned(16))) unsigned char lds[];
    Frame F;
    F.lds = (LAS unsigned char*)lds;
    F.MISC = (volatile LAS unsigned*)(F.lds + MISC_OFF);
    F.tid = threadIdx.x; F.lane = F.tid & 63; F.wave = __builtin_amdgcn_readfirstlane(F.tid >> 6);
    F.G = gridDim.x; { const int bx = blockIdx.x; F.vcu = (F.G % 8 == 0) ? (bx % 8) * (F.G / 8) + bx / 8 : bx; }
    F.ws = args.ws; F.out = args.out;
#pragma unroll
    for (int i = 0; i < 22; ++i) F.in[i] = args.in[i];
    F.ctl = (gu32*)(F.ws + WS_CTL);
    for (int u = F.tid; u < (LDS_BYTES - LDSCTL_OFF) / 4; u += NWAVES * 64) ((LAS unsigned*)(F.lds + LDSCTL_OFF))[u] = 0u;
    __syncthreads();
    XcdBarrier bar; bar.bar = (unsigned*)(F.ctl + CW_BAR); bar.x = 0; bar.st = nullptr;
    if (N_LAUNCHES == 1) bar = xcd_barrier_post((unsigned*)(F.ctl + CW_BAR), F.MISC + 8);
    const int lo = args.ph_lo, hi = args.ph_hi;
#define IN(k) (lo <= (k) && (k) < hi)
#define BOTH(k) (IN(k) && IN((k) + 1))
#define GRID_BAR() do { if (N_LAUNCHES == 1) xcd_barrier(bar); } while (0)

    if (IN(0)) { p0_prologue(F); if (BOTH(0)) GRID_BAR(); }
    if (IN(1)) {
        pg8::Gemm g{(const pg8::bf16_t*)(F.ws + WS_XB), (const pg8::bf16_t*)(F.ws + WS_WIN), MR, NPROJ, DM};
        pg8::StaticOrder S; S.init(MR, NPROJ, F.G, (int)blockIdx.x);
        pg8::EpiIn E{(pg8::bf16_t*)(F.ws + WS_H), F.out + O_KP, F.out + O_VP, F.out + O_KS, F.out + O_VS};
        pg8::gemm_phase<pg8::EpiIn, pg8::StaticOrder, true, true>(F.lds + RING_OFF, g, S, E);
        if (BOTH(1)) GRID_BAR();
    }

    if (IN(2)) {
        if (F.vcu < 2 * NGRP) ssm_fast_block(F, F.vcu >> 6, F.vcu & 63);
        LAS int* bkt = (LAS int*)(F.lds + RING_OFF);
        for (int e = F.tid; e < 387; e += NWAVES * 64) { const int p = e / 129, j = e - p * 129, d = p == 0 ? 1 : (p == 1 ? 4 : 16); bkt[e] = t5_bucket(j * d); }
        __syncthreads();
        const int gw = F.vcu * NWAVES + F.wave, NGW = F.G * NWAVES;
        for (int task = gw; task < 32 * NGRP; task += NGW) { const int db = task >> 6, g = task & 63;
            ssm_seq(F, g, (size_t)M_P + db * 4, 4, F.in[4] + (size_t)task * NST, F.in[5] + (size_t)task * NST, F.out + O_SRS + (size_t)task * NST, F.out + O_SIS + (size_t)task * NST); }
        for (int task = gw; task < M_S * NHEAD; task += NGW) attn_simple_task<true>(F, task, bkt);
        for (int u = F.vcu; u < 512; u += F.G) attn_fast_unit(F, u >> 8, (u >> 4) & 15, u & 15);
        if (BOTH(2)) GRID_BAR();
    }
    if (IN(3)) {
        pg8::Gemm g{(const pg8::bf16_t*)(F.ws + WS_Z), (const pg8::bf16_t*)(F.ws + WS_WGLU), MR, 1024, 1024};
        pg8::StaticOrder S; S.init(MR, 1024, F.G, (int)blockIdx.x);
        pg8::EpiGlu E{(const pg8::bf16_t*)(F.ws + WS_Z), (const pg8::bf16_t*)(F.ws + WS_H) + 5 * HREG, F.in[19], (pg8::bf16_t*)(F.ws + WS_BR)};
        pg8::gemm_phase<pg8::EpiGlu, pg8::StaticOrder, true, true>(F.lds + RING_OFF, g, S, E);
        if (BOTH(3)) GRID_BAR();
    }
    if (IN(4)) {
        pg8::Gemm g{(const pg8::bf16_t*)(F.ws + WS_BR), (const pg8::bf16_t*)(F.ws + WS_WOUT), MR, DM, DM};
        pg8::StaticOrder S; S.init(MR, DM, F.G, (int)blockIdx.x);
        pg8::EpiOut E{F.in[0], F.in[1], F.in[8], F.out + O_YP, F.out + O_YS, DN_ALPHA};
        pg8::gemm_phase<pg8::EpiOut, pg8::StaticOrder, true, true>(F.lds + RING_OFF, g, S, E);
        if (BOTH(4)) GRID_BAR();
    }
    if (IN(5)) {
        const int gw = F.vcu * NWAVES + F.wave, NGW = F.G * NWAVES;
        for (int m = gw; m < M_TOT; m += NGW) ln_row_inplace(F, m < M_P ? F.out + O_YP + (size_t)m * DM : F.out + O_YS + (size_t)(m - M_P) * DM);
    }
#undef IN
#undef BOTH
}

extern "C" void kernel_launch(void* const* d_in, const int* in_sizes, int n_in, void* d_out, int out_size, void* d_ws, size_t ws_size, hipStream_t stream) {
    static int grid = 0;
    if (grid == 0) {
        if (n_in != 22 || (size_t)out_size != O_TOTAL || ws_size < WS_END) { fprintf(stderr, "kernel_launch: unexpected shapes: n_in %d out %d ws %zu\n", n_in, out_size, ws_size); grid = -1; return; }
        int dev = 0, cus = 0, per_cu = 0;
        if (hipGetDevice(&dev) != hipSuccess || hipDeviceGetAttribute(&cus, hipDeviceAttributeMultiprocessorCount, dev) != hipSuccess) { grid = -1; return; }
        if (hipFuncSetAttribute((const void*)fwd_kernel, hipFuncAttributeMaxDynamicSharedMemorySize, LDS_BYTES) != hipSuccess) { fprintf(stderr, "kernel_launch: hipFuncSetAttribute failed\n"); grid = -1; return; }
        if (hipOccupancyMaxActiveBlocksPerMultiprocessor(&per_cu, (const void*)fwd_kernel, NWAVES * 64, LDS_BYTES) != hipSuccess || per_cu < 1) { fprintf(stderr, "kernel_launch: occupancy query says %d blocks/CU\n", per_cu); (void)hipGetLastError(); grid = -1; return; }
        grid = cus;
    }
    if (grid < 0) return;
    if (hipMemsetAsync((char*)d_ws + WS_CTL, 0, CTL_ZERO_BYTES, stream) != hipSuccess) return;
    Args a{};
    for (int i = 0; i < 22; ++i) a.in[i] = (const float*)d_in[i];
    a.out = (float*)d_out; a.ws = (unsigned char*)d_ws;
    for (int li = 0; li < N_LAUNCHES; ++li) {
        a.ph_lo = (N_LAUNCHES == 1) ? 0 : li; a.ph_hi = (N_LAUNCHES == 1) ? N_PHASES : li + 1; a.li = li;
        hipLaunchKernelGGL(fwd_kernel, dim3(grid), dim3(NWAVES * 64), LDS_BYTES, stream, a);
    }
}
```

```cpp
#include <hip/hip_runtime.h>
#include <cstdio>
#include <cstdint>
#include <cmath>
namespace pg8 {
#define PG8_LAS __attribute__((address_space(3)))
typedef unsigned short bf16_t;
typedef short bf16x8 __attribute__((ext_vector_type(8)));
typedef float f32x4 __attribute__((ext_vector_type(4)));
typedef unsigned u32x4 __attribute__((ext_vector_type(4)));
constexpr int BM = 256, BK = 64, HALF = 128, HTB = HALF * BK * 2  , STAGE_BYTES = 8 * HTB, NXCD = 8, WGM = 8;

__host__ __device__ __forceinline__ int lds_byte(int r, int c) { const int st = (r >> 4) * 2 + (c >> 5), rr = r & 15, cc = c & 31, ob = rr * 64 + cc * 2; return st * 1024 + (ob ^ (((ob >> 9) & 1) << 5)); }
__host__ __device__ __forceinline__ void stage_rc(int b, int& R, int& C) { const int st = b / 1024, sb = b % 1024, swz = sb ^ (((sb >> 9) & 1) << 5); R = (st >> 1) * 16 + swz / 64; C = (st & 1) * 32 + (swz % 64) / 2; }
__host__ __device__ __forceinline__ int perm32(int rho) { const int n = rho >> 4, i = rho & 15; return 8 * (i >> 2) + 4 * n + (i & 3); }

struct Unit { int pm, pn; };
struct Gemm { const bf16_t* A; const bf16_t* Bt; int M, N, K; };

struct StaticOrder {
    int nM, nN, nwg, G, c;
    __host__ __device__ void init(int M, int N, int G_, int c_) { nM = M / BM; nN = N / BM; nwg = nM * nN; G = G_; c = c_; }
    __host__ __device__ bool next(int i, Unit& u) const {
        const long L = (long)i * G + c; if (L >= nwg) return false;
        int wgid = (int)L; { const int q = nwg / NXCD, r = nwg % NXCD, xcd = wgid % NXCD, off = wgid / NXCD; wgid = (xcd < r ? xcd * (q + 1) : r * (q + 1) + (xcd - r) * q) + off; }
        const int nig = WGM * nN, gid = wgid / nig, fm = gid * WGM, gsz = (nM - fm) < WGM ? (nM - fm) : WGM;
        u.pm = fm + ((wgid % nig) % gsz); u.pn = (wgid % nig) / gsz; return true;
    }
    __device__ __forceinline__ void a_ready(const Unit&) const {}
    __device__ __forceinline__ void done(const Unit&) const {}
};

__device__ __forceinline__ unsigned cvt_pk_bf16(float lo, float hi) { unsigned r; asm volatile("v_cvt_pk_bf16_f32 %0, %1, %2" : "=v"(r) : "v"(lo), "v"(hi)); return r; }
__device__ __forceinline__ float silu_f(float v) { return v * __builtin_amdgcn_rcpf(1.0f + __expf(-v)); }
constexpr int M_P = 16384, M_S = 128, M_TOT = M_P + M_S, MR = 16640;
constexpr int DM = 2048, NPROJ = 6144, DA = 1024;
constexpr float QSCALE = 0.125f * 1.4426950408889634f;
typedef float f32x2 __attribute__((ext_vector_type(2)));

struct EpiIn {
    static constexpr bool PERM = true, AFTER_DRAIN = false;
    bf16_t* H; float* kp; float* vp; float* ks; float* vs;
    __device__ __forceinline__ void operator()(const f32x4 (&acc)[2][2][4][2], const Unit& u, int wr, int wc, int fr, int fq) const {
        const int region = u.pn >> 2, colt = (u.pn & 3) * BM;
        bf16_t* base = H + (size_t)region * ((size_t)MR * DA);
        const int row0 = u.pm * BM + wr * 64 + fr, col0 = colt + wc * 32 + 8 * fq;
        float* fo_p = region == 1 ? kp : vp; float* fo_s = region == 1 ? ks : vs;
#pragma unroll
        for (int ai = 0; ai < 2; ++ai)
#pragma unroll
            for (int m = 0; m < 4; ++m) {
                const int row = row0 + ai * HALF + m * 16;
                bf16_t* rowp = base + (size_t)row * DA + col0;
                float* frow = nullptr;
                if (region == 1 || region == 2) {
                    if (row < M_P) { const int b = row >> 13, t = row & 8191; if (t >= 6144) frow = fo_p + ((size_t)(b * 2048 + (t - 6144))) * DA + col0; }
                    else if (row < M_TOT) frow = fo_s + (size_t)(row - M_P) * DA + col0;
                }
#pragma unroll
                for (int bj = 0; bj < 2; ++bj) {
                    f32x4 v0 = acc[ai][bj][m][0], v1 = acc[ai][bj][m][1];
                    if (region == 0) { v0 = v0 * QSCALE; v1 = v1 * QSCALE; }
                    if (region == 3 || region == 5) {
#pragma unroll
                        for (int e = 0; e < 4; ++e) { v0[e] = silu_f(v0[e]); v1[e] = silu_f(v1[e]); }
                    }
                    u32x4 w; w.x = cvt_pk_bf16(v0[0], v0[1]); w.y = cvt_pk_bf16(v0[2], v0[3]); w.z = cvt_pk_bf16(v1[0], v1[1]); w.w = cvt_pk_bf16(v1[2], v1[3]);
                    *(u32x4*)(rowp + bj * HALF) = w;
                    if (frow) { *(f32x4*)(frow + bj * HALF) = v0; *(f32x4*)(frow + bj * HALF + 4) = v1; }
                }
            }
    }
};
struct EpiGlu {
    static constexpr bool PERM = true, AFTER_DRAIN = false;
    const bf16_t* Z; const bf16_t* GS; const float* bias; bf16_t* BR;
    __device__ __forceinline__ void operator()(const f32x4 (&acc)[2][2][4][2], const Unit& u, int wr, int wc, int fr, int fq) const {
        const int row0 = u.pm * BM + wr * 64 + fr, col0 = u.pn * BM + wc * 32 + 8 * fq;
        f32x4 bv[2][2];
#pragma unroll
        for (int bj = 0; bj < 2; ++bj)
#pragma unroll
            for (int n = 0; n < 2; ++n) bv[bj][n] = *(const f32x4*)(bias + col0 + bj * HALF + 4 * n);
#pragma unroll
        for (int ai = 0; ai < 2; ++ai)
#pragma unroll
            for (int m = 0; m < 4; ++m) {
                const size_t row = (size_t)(row0 + ai * HALF + m * 16);
#pragma unroll
                for (int bj = 0; bj < 2; ++bj) {
                    const int col = col0 + bj * HALF;
                    const u32x4 zw = *(const u32x4*)(Z + row * 1024 + col), gw = *(const u32x4*)(GS + row * 1024 + col);
                    const f32x4 a0 = acc[ai][bj][m][0] + bv[bj][0], a1 = acc[ai][bj][m][1] + bv[bj][1];
                    float o[8];
#pragma unroll
                    for (int e = 0; e < 8; ++e) {
                        const unsigned zz = zw[e >> 1], gg = gw[e >> 1];
                        const float zf = __builtin_bit_cast(float, (e & 1) ? (zz & 0xffff0000u) : (zz << 16));
                        const float gf = __builtin_bit_cast(float, (e & 1) ? (gg & 0xffff0000u) : (gg << 16));
                        const float a = e < 4 ? a0[e & 3] : a1[e & 3];
                        o[e] = zf * __builtin_amdgcn_rcpf(1.0f + __expf(-a)) * gf;
                    }
                    u32x4 w; w.x = cvt_pk_bf16(o[0], o[1]); w.y = cvt_pk_bf16(o[2], o[3]); w.z = cvt_pk_bf16(o[4], o[5]); w.w = cvt_pk_bf16(o[6], o[7]);
                    *(u32x4*)(BR + row * 2048 + 1024 + col) = w;
                }
            }
    }
};
struct EpiOut {
    static constexpr bool PERM = false, AFTER_DRAIN = false;
    const float* xp; const float* xs; const float* bias; float* yp; float* ys; float alpha;
    __device__ __forceinline__ void operator()(const f32x4 (&acc)[2][2][4][2], const Unit& u, int wr, int wc, int fr, int fq) const {
        const int row0 = u.pm * BM + wr * 64 + fr, col0 = u.pn * BM + wc * 32 + 4 * fq;
        f32x4 bv[2][2];
#pragma unroll
        for (int bj = 0; bj < 2; ++bj)
#pragma unroll
            for (int n = 0; n < 2; ++n) bv[bj][n] = *(const f32x4*)(bias + col0 + bj * HALF + n * 16);
#pragma unroll
        for (int ai = 0; ai < 2; ++ai)
#pragma unroll
            for (int m = 0; m < 4; ++m) {
                const int row = row0 + ai * HALF + m * 16;
                if (row < M_TOT) {
                    const float* xr = row < M_P ? xp + (size_t)row * DM : xs + (size_t)(row - M_P) * DM;
                    float* yr = row < M_P ? yp + (size_t)row * DM : ys + (size_t)(row - M_P) * DM;
#pragma unroll
                    for (int bj = 0; bj < 2; ++bj)
#pragma unroll
                        for (int n = 0; n < 2; ++n) { const int col = col0 + bj * HALF + n * 16;
                            const f32x4 xv = *(const f32x4*)(xr + col);
                            *(f32x4*)(yr + col) = acc[ai][bj][m][n] + bv[bj][n] + xv * alpha; }
                }
            }
    }
};
template <class Epi, class Sched, bool ALIGN_EPI = false, bool SP2 = false>
__device__ __forceinline__ void gemm_phase(PG8_LAS unsigned char* lds, const Gemm g, const Sched& S, const Epi& E) {
    const int tid = threadIdx.x, wid = __builtin_amdgcn_readfirstlane(tid >> 6), lane = tid & 63, wr = wid >> 2, wc = wid & 3, fr = lane & 15, fq = lane >> 4;
    const int K = g.K, nt = K / BK;
    unsigned voffA[2], voffB[2];
#pragma unroll
    for (int i = 0; i < 2; ++i) { int R, C; stage_rc(tid * 16 + i * 8192, R, C); const int Rb = Epi::PERM ? ((R & ~31) + perm32(R & 31)) : R;
        voffA[i] = (unsigned)(R * K + C) * 2u; voffB[i] = (unsigned)(Rb * K + C) * 2u; }
    const size_t kstep = (size_t)(BK * 2);
    const size_t hstep = (size_t)HALF * K * 2;
    const size_t tstep = 2 * hstep;
    const unsigned ldsw = (unsigned)wid * 1024u;
    const int aoff = lds_byte(wr * 64 + fr, fq * 8), boff = lds_byte(wc * 32 + fr, fq * 8);
#define PG8_SA(b, h) (((b) * 2 + (h)) * HTB)
#define PG8_SB(b, h) ((4 + (b) * 2 + (h)) * HTB)
#define PG8_STAGE(bufoff, gbase, voff) do { _Pragma("unroll") for (int _i = 0; _i < 2; ++_i) \
        __builtin_amdgcn_global_load_lds((const unsigned*)((const char*)(gbase) + (voff)[_i]), (PG8_LAS unsigned*)(lds + (bufoff) + ldsw + _i * 8192), 16, 0, 0); } while (0)
#define PG8_LDA(dst, b, h) do { _Pragma("unroll") for (int m = 0; m < 4; ++m) _Pragma("unroll") for (int k = 0; k < 2; ++k) dst[m][k] = *(const PG8_LAS bf16x8*)(lds + PG8_SA(b, h) + aoff + m * 2048 + k * 1024); } while (0)
#define PG8_LDB(dst, b, h) do { _Pragma("unroll") for (int n = 0; n < 2; ++n) _Pragma("unroll") for (int k = 0; k < 2; ++k) dst[n][k] = *(const PG8_LAS bf16x8*)(lds + PG8_SB(b, h) + boff + n * 2048 + k * 1024); } while (0)
#define PG8_MMA(ai, bj, At, Bt) do { __builtin_amdgcn_s_setprio(1); _Pragma("unroll") for (int m = 0; m < 4; ++m) _Pragma("unroll") for (int n = 0; n < 2; ++n) _Pragma("unroll") for (int k = 0; k < 2; ++k) \
        acc[ai][bj][m][n] = __builtin_amdgcn_mfma_f32_16x16x32_bf16(Bt[n][k], At[m][k], acc[ai][bj][m][n], 0, 0, 0); __builtin_amdgcn_s_setprio(0); } while (0)
#define PG8_WAIT_V(n) asm volatile("s_waitcnt vmcnt(" #n ")" ::: "memory")
#define PG8_WAIT_L(n) asm volatile("s_waitcnt lgkmcnt(" #n ")" ::: "memory")
#define PG8_BAR __builtin_amdgcn_s_barrier()
#define PG8_SCHED __builtin_amdgcn_sched_barrier(0)
    Unit cur, nxt; int ui = 0;
    if (!S.next(0, cur)) return;
    f32x4 acc[2][2][4][2];
#pragma unroll
    for (int a = 0; a < 2; ++a)
#pragma unroll
        for (int b = 0; b < 2; ++b)
#pragma unroll
            for (int m = 0; m < 4; ++m)
#pragma unroll
                for (int n = 0; n < 2; ++n) acc[a][b][m][n] = (f32x4){0.f, 0.f, 0.f, 0.f};
    bf16x8 At[4][2], B0[2][2], B1[2][2];
    const char* cA = (const char*)g.A + (size_t)cur.pm * tstep; const char* cB = (const char*)g.Bt + (size_t)cur.pn * tstep;
    S.a_ready(cur);
    if constexpr (SP2) {
        PG8_STAGE(PG8_SB(0, 0), cB, voffB); PG8_STAGE(PG8_SB(0, 1), cB + hstep, voffB); PG8_STAGE(PG8_SA(0, 0), cA, voffA); PG8_STAGE(PG8_SA(0, 1), cA + hstep, voffA);
        if (wr == 1) PG8_BAR;
        PG8_WAIT_V(2); PG8_BAR;
        PG8_STAGE(PG8_SB(1, 0), cB + kstep, voffB); PG8_STAGE(PG8_SA(1, 0), cA + kstep, voffA); PG8_STAGE(PG8_SB(1, 1), cB + hstep + kstep, voffB);
        PG8_WAIT_V(6); PG8_BAR;
    } else {
        PG8_STAGE(PG8_SB(0, 0), cB, voffB); PG8_STAGE(PG8_SA(0, 0), cA, voffA); PG8_STAGE(PG8_SB(0, 1), cB + hstep, voffB); PG8_STAGE(PG8_SA(0, 1), cA + hstep, voffA);
        if (wr == 1) PG8_BAR;
        PG8_WAIT_V(4); PG8_BAR;
        PG8_STAGE(PG8_SB(1, 0), cB + kstep, voffB); PG8_STAGE(PG8_SA(1, 0), cA + kstep, voffA); PG8_STAGE(PG8_SB(1, 1), cB + hstep + kstep, voffB);
        PG8_WAIT_V(6); PG8_BAR;
    }
    for (;;) {
        const bool has_next = S.next(ui + 1, nxt);
        const char* nA = has_next ? (const char*)g.A + (size_t)nxt.pm * tstep : cA; const char* nB = has_next ? (const char*)g.Bt + (size_t)nxt.pn * tstep : cB;
        for (int t = 0; t < nt; t += 2) {
            const bool last = (t == nt - 2);
            const char* a1 = cA + (size_t)(t + 1) * kstep;
            const char* a2 = last ? nA : cA + (size_t)(t + 2) * kstep; const char* b2 = last ? nB : cB + (size_t)(t + 2) * kstep;
            const char* a3 = a2 + kstep; const char* b3 = b2 + kstep;
            if (last && has_next) S.a_ready(nxt);
            if constexpr (SP2) {
            PG8_LDB(B0, 0, 0); PG8_LDB(B1, 0, 1); PG8_SCHED; PG8_LDA(At, 0, 0); PG8_STAGE(PG8_SA(1, 1), a1 + hstep, voffA);
            PG8_WAIT_V(8); PG8_WAIT_L(0); PG8_BAR; PG8_MMA(0, 0, At, B0); PG8_MMA(0, 1, At, B1); PG8_BAR; PG8_SCHED;
            PG8_LDA(At, 0, 1); PG8_STAGE(PG8_SB(0, 0), b2, voffB); PG8_STAGE(PG8_SB(0, 1), b2 + hstep, voffB); PG8_STAGE(PG8_SA(0, 0), a2, voffA);
            PG8_WAIT_V(8); PG8_WAIT_L(0); PG8_BAR; PG8_MMA(1, 0, At, B0); PG8_MMA(1, 1, At, B1); PG8_BAR; PG8_SCHED;
            PG8_LDB(B0, 1, 0); PG8_LDB(B1, 1, 1); PG8_SCHED; PG8_LDA(At, 1, 0); PG8_STAGE(PG8_SA(0, 1), a2 + hstep, voffA);
            PG8_WAIT_V(8); PG8_WAIT_L(0); PG8_BAR; PG8_MMA(0, 0, At, B0); PG8_MMA(0, 1, At, B1); PG8_BAR; PG8_SCHED;
            PG8_LDA(At, 1, 1); PG8_STAGE(PG8_SB(1, 0), b3, voffB); PG8_STAGE(PG8_SB(1, 1), b3 + hstep, voffB); PG8_STAGE(PG8_SA(1, 0), a3, voffA);
            PG8_WAIT_V(8); PG8_WAIT_L(0); PG8_BAR; PG8_MMA(1, 0, At, B0); PG8_MMA(1, 1, At, B1); PG8_BAR; PG8_SCHED;
            } else {
            PG8_LDB(B0, 0, 0); PG8_SCHED; PG8_LDA(At, 0, 0); PG8_STAGE(PG8_SA(1, 1), a1 + hstep, voffA);
            PG8_WAIT_L(8); PG8_BAR; PG8_WAIT_L(0); PG8_MMA(0, 0, At, B0); PG8_BAR; PG8_SCHED;
            PG8_LDB(B1, 0, 1); PG8_STAGE(PG8_SB(0, 0), b2, voffB);
            PG8_BAR; PG8_WAIT_L(0); PG8_MMA(0, 1, At, B1); PG8_BAR;
            PG8_LDA(At, 0, 1); PG8_STAGE(PG8_SA(0, 0), a2, voffA);
            PG8_BAR; PG8_WAIT_L(0); PG8_MMA(1, 0, At, B0); PG8_BAR; PG8_SCHED;
            PG8_STAGE(PG8_SB(0, 1), b2 + hstep, voffB);
            PG8_WAIT_V(6); PG8_BAR; PG8_MMA(1, 1, At, B1); PG8_BAR;
            PG8_LDB(B0, 1, 0); PG8_SCHED; PG8_LDA(At, 1, 0); PG8_STAGE(PG8_SA(0, 1), a2 + hstep, voffA);
            PG8_WAIT_L(8); PG8_BAR; PG8_WAIT_L(0); PG8_MMA(0, 0, At, B0); PG8_BAR; PG8_SCHED;
            PG8_LDB(B1, 1, 1); PG8_STAGE(PG8_SB(1, 0), b3, voffB);
            PG8_BAR; PG8_WAIT_L(0); PG8_MMA(0, 1, At, B1); PG8_BAR;
            PG8_LDA(At, 1, 1); PG8_STAGE(PG8_SA(1, 0), a3, voffA);
            PG8_BAR; PG8_WAIT_L(0); PG8_MMA(1, 0, At, B0); PG8_BAR; PG8_SCHED;
            PG8_STAGE(PG8_SB(1, 1), b3 + hstep, voffB);
            PG8_WAIT_V(6); PG8_BAR; PG8_MMA(1, 1, At, B1); PG8_BAR;
            }
        }
        if constexpr (ALIGN_EPI) { if (wr == 0) PG8_BAR; }
        if constexpr (!Epi::AFTER_DRAIN) { E(acc, cur, wr, wc, fr, fq); S.done(cur); }
        if (!has_next) break;
#pragma unroll
        for (int a = 0; a < 2; ++a)
#pragma unroll
            for (int b = 0; b < 2; ++b)
#pragma unroll
                for (int m = 0; m < 4; ++m)
#pragma unroll
                    for (int n = 0; n < 2; ++n) acc[a][b][m][n] = (f32x4){0.f, 0.f, 0.f, 0.f};
        cur = nxt; cA = nA; cB = nB; ++ui;
        if constexpr (ALIGN_EPI) { if (wr == 1) PG8_BAR; }
    }
    PG8_WAIT_V(0);
    if constexpr (!ALIGN_EPI) { if (wr == 0) PG8_BAR; }
    PG8_BAR;
    if constexpr (Epi::AFTER_DRAIN) { E.fused(acc, cur, wr, wc, fr, fq, lds, wid, lane); S.done(cur); }
#undef PG8_SA
#undef PG8_SB
#undef PG8_STAGE
#undef PG8_LDA
#undef PG8_LDB
#undef PG8_MMA
#undef PG8_WAIT_V
#undef PG8_WAIT_L
#undef PG8_BAR
#undef PG8_SCHED
}
}
#define GAS __attribute__((address_space(1)))
#define LAS __attribute__((address_space(3)))
typedef unsigned short bf16;
typedef unsigned v4u __attribute__((ext_vector_type(4)));
typedef float f32x4 __attribute__((ext_vector_type(4)));
typedef short bf16x8 __attribute__((ext_vector_type(8)));
typedef GAS unsigned gu32;
typedef GAS unsigned long long gu64;
#define RLX_AGENT __ATOMIC_RELAXED, __HIP_MEMORY_SCOPE_AGENT
#define LDS_WAIT() asm volatile("s_waitcnt lgkmcnt(0)" ::: "memory")
#define VM_WAIT() asm volatile("s_waitcnt vmcnt(0)" ::: "memory")
__device__ __forceinline__ unsigned long long rt() { return __builtin_amdgcn_s_memrealtime(); }
__device__ __forceinline__ unsigned f2bf(float f) { unsigned u = __builtin_bit_cast(unsigned, f); return (u + 0x7fffu + ((u >> 16) & 1u)) >> 16; }
__device__ __forceinline__ unsigned pk2(float lo, float hi) { return f2bf(lo) | (f2bf(hi) << 16); }

#define XB_TMO      128
#define XB_XCNT(j)  (256  + 64 * (j))
#define XB_XSUB(j)  (1280 + 64 * (j))
#define XB_XGEN(j)  (2304 + 64 * (j))
#define XB_TOP      3328
#define XB_TOPGEN   3392
#define XCD_BAR_WORDS 3456
#define XB_SPIN_CAP (1u << 18)

__device__ __forceinline__ unsigned xb_ld(unsigned* p)              { return __hip_atomic_load(p, __ATOMIC_RELAXED, __HIP_MEMORY_SCOPE_AGENT); }
__device__ __forceinline__ unsigned xb_add(unsigned* p, unsigned v) { return __hip_atomic_fetch_add(p, v, __ATOMIC_RELAXED, __HIP_MEMORY_SCOPE_AGENT); }
__device__ __forceinline__ unsigned xb_xcc_id() { return (unsigned)__builtin_amdgcn_s_getreg((3 << 11) | 20) & 0xFu; }
#define XB_SPIN(cond, bar) do { unsigned _sp = 0; while (cond) { __builtin_amdgcn_s_sleep(1); \
    if ((++_sp & 255u) == 0u) { if (xb_ld(&(bar)[XB_TMO])) break; if (_sp > XB_SPIN_CAP) { atomicAdd(&(bar)[XB_TMO], 1u); break; } } } } while (0)

struct XcdBarrier {
    unsigned* bar; unsigned x;
    volatile LAS unsigned* st;
};

__device__ __forceinline__ XcdBarrier xcd_barrier_post(unsigned* bar, volatile LAS unsigned* st) {
    XcdBarrier b; b.bar = bar; b.x = xb_xcc_id(); b.st = st;
    if (threadIdx.x == 0) (void)xb_add(&bar[XB_XCNT(b.x)], 1u);
    return b;
}
__device__ __forceinline__ void xcd_barrier_complete(unsigned* bar, unsigned x, unsigned& nloc, unsigned& nx) {
    const unsigned G = gridDim.x * gridDim.y * gridDim.z;
    unsigned sum, cnt, mine, sp = 0u;
    for (;;) {
        sum = 0u; cnt = 0u; mine = 0u;
#pragma unroll
        for (unsigned j = 0; j < 16; ++j) { const unsigned c = xb_ld(&bar[XB_XCNT(j)]); sum += c; cnt += (c > 0u) ? 1u : 0u; mine = (j == x) ? c : mine; }
        if (sum == G) break;
        __builtin_amdgcn_s_sleep(1);
        if ((++sp & 255u) == 0u) { if (xb_ld(&bar[XB_TMO])) break; if (sp > XB_SPIN_CAP) { atomicAdd(&bar[XB_TMO], 1u); break; } }
    }
    nloc = mine > 0u ? mine : 1u; nx = cnt > 0u ? cnt : 1u;
}

__device__ __forceinline__ void xcd_barrier(const XcdBarrier& b) {
    asm volatile("s_waitcnt vmcnt(0)" ::: "memory");
    __syncthreads();
    if (threadIdx.x == 0) {
        unsigned* bar = b.bar;
        __builtin_amdgcn_s_waitcnt(0);
        unsigned nloc = b.st[0], nx = b.st[1];
        if (nloc == 0u) { xcd_barrier_complete(bar, b.x, nloc, nx); b.st[0] = nloc; b.st[1] = nx; }
        const unsigned old = xb_add(&bar[XB_XSUB(b.x)], 1u);
        const unsigned gen = old / nloc;
        if (old + 1u == (gen + 1u) * nloc) {
            __builtin_amdgcn_fence(__ATOMIC_RELEASE, "agent");
            asm volatile("s_waitcnt vmcnt(0)" ::: "memory");
            const unsigned og = xb_add(&bar[XB_TOP], 1u);
            const unsigned tg = og / nx;
            if (og + 1u == (tg + 1u) * nx) xb_add(&bar[XB_TOPGEN], 1u);
            else XB_SPIN(xb_ld(&bar[XB_TOPGEN]) == tg, bar);
            __builtin_amdgcn_fence(__ATOMIC_ACQUIRE, "agent");
            xb_add(&bar[XB_XGEN(b.x)], 1u);
            asm volatile("s_waitcnt vmcnt(0)" ::: "memory");
        } else {
            XB_SPIN(xb_ld(&bar[XB_XGEN(b.x)]) == gen, bar);
            __builtin_amdgcn_fence(__ATOMIC_ACQUIRE, "agent");
            asm volatile("s_waitcnt vmcnt(0)" ::: "memory");
        }
    }
    __syncthreads();
}
__device__ __forceinline__ float bf2f(unsigned short h) { return __builtin_bit_cast(float, (unsigned)h << 16); }
using pg8::M_P; using pg8::M_S; using pg8::M_TOT; using pg8::MR; using pg8::DM; using pg8::NPROJ; using pg8::DA;
constexpr int NWAVES = 8;
constexpr int SEQ = 8192, NHEAD = 16, HD = 64, NGRP = 64, NST = 64, NCH = 16;
constexpr float LN_EPS = 1e-5f;
constexpr float DN_ALPHA = 1.189207115002721f;
constexpr size_t MiB = 1u << 20;
constexpr size_t WS_CTL = 0, CTL_ZERO_BYTES = 1 * MiB;
constexpr size_t WS_WIN = 2 * MiB;
constexpr size_t WS_WGLU = 26 * MiB;
constexpr size_t WS_WOUT = 28 * MiB;
constexpr size_t WS_SA = 36 * MiB;
constexpr size_t WS_BBAR = 37 * MiB;
constexpr size_t WS_XB = 64 * MiB;
constexpr size_t WS_H = 136 * MiB;
constexpr size_t WS_BR = 336 * MiB;
constexpr size_t WS_Z = 404 * MiB;
constexpr size_t WS_END = 440 * MiB;
constexpr size_t HREG = (size_t)MR * DA;
constexpr size_t O_YP = 0, O_YS = 33554432, O_KP = 33816576, O_VP = 38010880, O_SRP = 42205184, O_SIP = 42213376,
                 O_KS = 42221568, O_VS = 42352640, O_SRS = 42483712, O_SIS = 42614784, O_TOTAL = 42745856;
constexpr int CW_TMO = 0, CW_CODE = 1, CW_BAR = 4096, CW_Q = 16384;
constexpr int RING_OFF = 0, RING_BYTES = 131072;
constexpr int LDSCTL_OFF = 163328, MISC_OFF = LDSCTL_OFF + 320;
constexpr int LDS_BYTES = 163840;
struct Frame {
    LAS unsigned char* lds;
    volatile LAS unsigned* MISC;
    gu32* ctl;
    int tid, lane, wave;
    int vcu, G;
    const float* in[22]; float* out; unsigned char* ws;
};
__device__ __forceinline__ float wave_sum(float v) {
#pragma unroll
    for (int o = 1; o < 64; o <<= 1) v += __shfl_xor(v, o);
    return v;
}
__device__ __forceinline__ void p0_transpose_item(const float* W, int K, int N, bf16* WT, LAS float* scr, int item, int lane) {
    const int nblk = N / 32, kb = item / nblk, nb = item % nblk, k0 = 64 * kb, n0 = 32 * nb;
#pragma unroll 8
    for (int i = 0; i < 32; ++i) { const int kk = 2 * i + (lane >> 5); scr[kk * 33 + (lane & 31)] = W[(size_t)(k0 + kk) * N + n0 + (lane & 31)]; }
    LDS_WAIT(); asm volatile("" ::: "memory");
    const int c = lane & 7;
#pragma unroll
    for (int j = 0; j < 4; ++j) { const int n = (lane >> 3) + 8 * j; const LAS float* s = scr + (8 * c) * 33 + n;
        v4u o; o.x = pk2(s[0 * 33], s[1 * 33]); o.y = pk2(s[2 * 33], s[3 * 33]); o.z = pk2(s[4 * 33], s[5 * 33]); o.w = pk2(s[6 * 33], s[7 * 33]);
        *(GAS v4u*)(WT + (size_t)(n0 + n) * K + k0 + 8 * c) = o; }
    LDS_WAIT(); asm volatile("" ::: "memory");
}
__device__ __forceinline__ void sincos_d(double x, double& s, double& c) {
    const double TWO_PI = 6.283185307179586476925286766559;
    const double k = rint(x / TWO_PI);
    const double r = fma(-k, TWO_PI, x);
    const double y = r * 0.125, y2 = y * y;
    double sn = y * (1.0 - y2 / 6.0 * (1.0 - y2 / 20.0 * (1.0 - y2 / 42.0 * (1.0 - y2 / 72.0 * (1.0 - y2 / 110.0 * (1.0 - y2 / 156.0 * (1.0 - y2 / 210.0)))))));
    double cs = 1.0 - y2 / 2.0 * (1.0 - y2 / 12.0 * (1.0 - y2 / 30.0 * (1.0 - y2 / 56.0 * (1.0 - y2 / 90.0 * (1.0 - y2 / 132.0 * (1.0 - y2 / 182.0 * (1.0 - y2 / 240.0)))))));
#pragma unroll
    for (int i = 0; i < 3; ++i) { const double s2 = 2.0 * sn * cs, c2 = cs * cs - sn * sn; sn = s2; cs = c2; }
    s = sn; c = cs;
}
__device__ __forceinline__ void p0_prologue(Frame& F) {
    LAS float* scr = (LAS float*)(F.lds + RING_OFF + F.wave * 16384);
    const int gw = F.vcu * NWAVES + F.wave, NGW = F.G * NWAVES;
    constexpr int I_IN = (DM / 64) * (NPROJ / 32), I_GLU = (1024 / 64) * (1024 / 32), I_OUT = (DM / 64) * (DM / 32);
    constexpr int NITEMS = I_IN + I_GLU + I_OUT;
    for (int it = gw; it < NITEMS; it += NGW) {
        int r = it;
        if (r < I_IN) { p0_transpose_item(F.in[6], DM, NPROJ, (bf16*)(F.ws + WS_WIN), scr, r, F.lane); continue; } r -= I_IN;
        if (r < I_GLU) { p0_transpose_item(F.in[18], 1024, 1024, (bf16*)(F.ws + WS_WGLU), scr, r, F.lane); continue; } r -= I_GLU;
        p0_transpose_item(F.in[7], DM, DM, (bf16*)(F.ws + WS_WOUT), scr, r, F.lane);
    }
    bf16* XB = (bf16*)(F.ws + WS_XB);
    for (int m = gw; m < MR; m += NGW) {
        GAS unsigned long long* o8 = (GAS unsigned long long*)(XB + (size_t)m * DM) + F.lane;
        if (m < M_TOT) {
            const float* xrow = m < M_P ? F.in[0] + (size_t)m * DM : F.in[1] + (size_t)(m - M_P) * DM;
            const GAS f32x4* xr = (const GAS f32x4*)xrow + F.lane;
#pragma unroll
            for (int j = 0; j < 8; ++j) { const f32x4 v = xr[64 * j]; o8[64 * j] = (unsigned long long)pk2(v.x, v.y) | ((unsigned long long)pk2(v.z, v.w) << 32); }
        } else {
#pragma unroll
            for (int j = 0; j < 8; ++j) o8[64 * j] = 0ull;
        }
    }
    const int gt = F.vcu * (NWAVES * 64) + F.tid;
    if (gt < NGRP * NST) {
        const int g = gt >> 6;
        const double lr = fmin((double)F.in[10][gt], -1e-4), li = (double)F.in[11][gt];
        const double dt = exp((double)F.in[12][g]);
        const double mag = exp(lr * dt); double sn, cs; sincos_d(li * dt, sn, cs);
        double ar = mag * cs, ai = mag * sn;
        const double den = lr * lr + li * li, inv_re = lr / den, inv_im = -li / den;
        const double n_re = ar - 1.0, n_im = ai;
        const double cf_re = n_re * inv_re - n_im * inv_im, cf_im = n_re * inv_im + n_im * inv_re;
        float* SA = (float*)(F.ws + WS_SA) + (size_t)gt * 8;
        SA[0] = (float)ar; SA[1] = (float)ai;
        double pr = ar, pi = ai;
        for (int i = 0; i < 10; ++i) { const double t = pr * pr - pi * pi; pi = 2.0 * pr * pi; pr = t; if (i == 4) { SA[2] = (float)pr; SA[3] = (float)pi; } }
        SA[4] = (float)pr; SA[5] = (float)pi; SA[6] = 0.f; SA[7] = 0.f;
        float* BB = (float*)(F.ws + WS_BBAR) + (size_t)gt * 32;
        const float* br = F.in[13] + (size_t)gt * 16; const float* bi = F.in[14] + (size_t)gt * 16;
        for (int c = 0; c < 16; ++c) { const double x = br[c], y = bi[c]; BB[2 * c] = (float)(cf_re * x - cf_im * y); BB[2 * c + 1] = (float)(cf_re * y + cf_im * x); }
    }
}
__device__ __forceinline__ int t5_bucket(int dist) {
    if (dist < 16) return dist;
    const float v = logf((float)dist / 16.0f) / 4.852030263919617f * 16.0f;
    const int large = 16 + (int)v;
    return large < 31 ? large : 31;
}
__device__ __forceinline__ float gelu_tanh(float y) {
    const float a = 0.7978845608028654f * (y + 0.044715f * y * y * y);
    const float t = __expf(2.0f * a);
    return 0.5f * y * (2.0f - 2.0f * __builtin_amdgcn_rcpf(t + 1.0f));
}
template <bool SAMPLE>
__device__ __forceinline__ void attn_simple_task(Frame& F, int task, const LAS int* bkt, bf16* BRo) {
    const int h = task & 15, rowi = task >> 4;
    const bf16* Hq = (const bf16*)(F.ws + WS_H);
    const size_t qrow = SAMPLE ? (size_t)(M_P + rowi) : (size_t)rowi;
    const int b = SAMPLE ? (rowi >> 2) : (rowi >> 13), t = SAMPLE ? (2048 + (rowi & 3)) : (rowi & 8191);
    unsigned qp[32];
    { const v4u* qv = (const v4u*)(Hq + qrow * DA + h * HD);
#pragma unroll
      for (int i = 0; i < 8; ++i) { const v4u w = qv[i]; qp[4 * i] = w.x; qp[4 * i + 1] = w.y; qp[4 * i + 2] = w.z; qp[4 * i + 3] = w.w; } }
    const bf16* Kb = Hq + HREG; const bf16* Vb = Hq + 2 * HREG;
    const float* ck = F.in[2]; const float* cv = F.in[3]; const float* kn = F.out + O_KS; const float* vn = F.out + O_VS;
    LAS float* lgs = (LAS float*)(F.lds + RING_OFF + 4096 + F.wave * 2048);
    float mx = -INFINITY;
#pragma unroll 1
    for (int i = 0; i < 7; ++i) {
        const int e = F.lane + 64 * i; float v = -INFINITY;
        if (e < 387) {
            const int p = e / 129, j = e - p * 129, d = p == 0 ? 1 : (p == 1 ? 4 : 16), kt = t - j * d;
            if (kt >= 0) {
                float dot = 0.f;
                if (SAMPLE) {
                    const float* kr = kt < 2048 ? ck + (((size_t)b * 2048 + kt) * NHEAD + h) * HD : kn + ((size_t)(b * 4 + kt - 2048)) * DA + h * HD;
#pragma unroll
                    for (int c = 0; c < 16; ++c) { const f32x4 kv = *(const f32x4*)(kr + 4 * c); const unsigned q0 = qp[2 * c], q1 = qp[2 * c + 1];
                        dot += __builtin_bit_cast(float, q0 << 16) * kv.x + __builtin_bit_cast(float, q0 & 0xffff0000u) * kv.y + __builtin_bit_cast(float, q1 << 16) * kv.z + __builtin_bit_cast(float, q1 & 0xffff0000u) * kv.w; }
                } else {
                    const v4u* kr = (const v4u*)(Kb + ((size_t)b * SEQ + kt) * DA + h * HD);
#pragma unroll
                    for (int c = 0; c < 8; ++c) { const v4u kw = kr[c];
#pragma unroll
                        for (int x = 0; x < 4; ++x) { const unsigned kk = kw[x], qq = qp[4 * c + x];
                            dot += __builtin_bit_cast(float, qq << 16) * __builtin_bit_cast(float, kk << 16) + __builtin_bit_cast(float, qq & 0xffff0000u) * __builtin_bit_cast(float, kk & 0xffff0000u); } }
                }
                v = dot + F.in[9][bkt[e] * NHEAD + h] * 1.4426950408889634f;
            }
            lgs[e] = v;
        }
        mx = fmaxf(mx, v);
    }
#pragma unroll
    for (int o = 1; o < 64; o <<= 1) mx = fmaxf(mx, __shfl_xor(mx, o));
    float sum = 0.f;
#pragma unroll 1
    for (int i = 0; i < 7; ++i) { const int e = F.lane + 64 * i; if (e < 387) { const float pr = exp2f(lgs[e] - mx); lgs[e] = pr; sum += pr; } }
    sum = wave_sum(sum);
    LDS_WAIT(); asm volatile("" ::: "memory");
    float acc = 0.f;
#pragma unroll 1
    for (int p = 0; p < 3; ++p) {
        const int d = p == 0 ? 1 : (p == 1 ? 4 : 16);
#pragma unroll 4
        for (int j = 0; j < 129; ++j) {
            const int kt = t - j * d;
            if (kt < 0) break;
            const float pe = lgs[p * 129 + j];
            float vv;
            if (SAMPLE) vv = kt < 2048 ? cv[(((size_t)b * 2048 + kt) * NHEAD + h) * HD + F.lane] : vn[((size_t)(b * 4 + kt - 2048)) * DA + h * HD + F.lane];
            else vv = bf2f(Vb[((size_t)b * SEQ + kt) * DA + h * HD + F.lane]);
            acc += pe * vv;
        }
    }
    LDS_WAIT(); asm volatile("" ::: "memory");
    const float ga = bf2f(Hq[3 * HREG + qrow * DA + h * HD + F.lane]);
    BRo[qrow * 2048 + h * HD + F.lane] = (bf16)f2bf(acc / sum * ga);
}
__device__ __forceinline__ void ssm_seq(Frame& F, int g, size_t rowbase, int L, const float* x0r, const float* x0i, float* outr, float* outi, bf16* Z) {
    const int n = F.lane;
    const float* SA = (const float*)(F.ws + WS_SA) + (size_t)(g * NST + n) * 8;
    const float ar = SA[0], ai = SA[1];
    const float* BB = (const float*)(F.ws + WS_BBAR) + (size_t)(g * NST + n) * 32;
    float bbr[16], bbi[16], cre[16], cim[16];
#pragma unroll
    for (int c = 0; c < 16; ++c) { bbr[c] = BB[2 * c]; bbi[c] = BB[2 * c + 1]; cre[c] = F.in[15][(size_t)(g * NCH + c) * NST + n]; cim[c] = F.in[16][(size_t)(g * NCH + c) * NST + n]; }
    const float dsk = F.in[17][g * NCH + (n & 15)];
    float xr = x0r ? x0r[n] : 0.f, xi = x0i ? x0i[n] : 0.f;
    const bf16* U = (const bf16*)(F.ws + WS_H) + 4 * HREG;
    for (int t = 0; t < L; ++t) {
        const size_t row = rowbase + t;
        const v4u* up = (const v4u*)(U + row * DA + g * NCH);
        const v4u u0 = up[0], u1 = up[1];
        float u[16];
#pragma unroll
        for (int c = 0; c < 4; ++c) { u[2 * c] = __builtin_bit_cast(float, u0[c] << 16); u[2 * c + 1] = __builtin_bit_cast(float, u0[c] & 0xffff0000u); u[8 + 2 * c] = __builtin_bit_cast(float, u1[c] << 16); u[9 + 2 * c] = __builtin_bit_cast(float, u1[c] & 0xffff0000u); }
        float bur = 0.f, bui = 0.f;
#pragma unroll
        for (int c = 0; c < 16; ++c) { bur += bbr[c] * u[c]; bui += bbi[c] * u[c]; }
        const float nxr = ar * xr - ai * xi + bur, nxi = ar * xi + ai * xr + bui;
        xr = nxr; xi = nxi;
        float yv = 0.f, uv = 0.f;
#pragma unroll
        for (int c = 0; c < 16; ++c) { const float s = wave_sum(cre[c] * xr - cim[c] * xi); if ((n & 15) == c) { yv = s; uv = u[c]; } }
        yv += dsk * uv;
        if (n < 16) Z[row * DA + g * NCH + n] = (bf16)f2bf(gelu_tanh(yv));
    }
    outr[n] = xr; outi[n] = xi;
}
__device__ __forceinline__ void ln_row_inplace(Frame& F, float* row) {
    GAS f32x4* xr = (GAS f32x4*)row + F.lane;
    f32x4 v[8]; float s = 0.f;
#pragma unroll
    for (int j = 0; j < 8; ++j) { v[j] = xr[64 * j]; s += (v[j].x + v[j].y) + (v[j].z + v[j].w); }
    const float mean = wave_sum(s) * (1.f / DM); float s2 = 0.f;
#pragma unroll
    for (int j = 0; j < 8; ++j) { v[j] = v[j] - mean; s2 += (v[j].x * v[j].x + v[j].y * v[j].y) + (v[j].z * v[j].z + v[j].w * v[j].w); }
    const float rstd = 1.f / sqrtf(wave_sum(s2) * (1.f / DM) + LN_EPS);
    const GAS f32x4* gp = (const GAS f32x4*)F.in[20] + F.lane; const GAS f32x4* bp = (const GAS f32x4*)F.in[21] + F.lane;
#pragma unroll
    for (int j = 0; j < 8; ++j) xr[64 * j] = v[j] * rstd * gp[64 * j] + bp[64 * j];
}
typedef float f32x16 __attribute__((ext_vector_type(16)));
typedef __bf16 bf16x2_t __attribute__((ext_vector_type(2)));
typedef float f32x2_t __attribute__((ext_vector_type(2)));
__device__ __forceinline__ unsigned cvtpk(float lo, float hi) { f32x2_t v = {lo, hi}; bf16x2_t b = __builtin_convertvector(v, bf16x2_t); return __builtin_bit_cast(unsigned, b); }
__device__ __forceinline__ bf16x8 pack8(float a0, float a1, float a2, float a3, float a4, float a5, float a6, float a7) {
    v4u w; w.x = cvtpk(a0, a1); w.y = cvtpk(a2, a3); w.z = cvtpk(a4, a5); w.w = cvtpk(a6, a7); return __builtin_bit_cast(bf16x8, w); }
constexpr int SSM_EP = 257;
constexpr int SSM_ST_OFF = 2 * 64 * SSM_EP * 4, SSM_A2T_OFF = SSM_ST_OFF + 4096, SSM_A1T_OFF = SSM_A2T_OFF + 8192, SSM_LDS_END = SSM_A1T_OFF + 5120;
__device__ __forceinline__ void ssm_fast_block(Frame& F, int b, int g) {
    const int lane = F.lane, w = F.wave, col = lane & 31, h = lane >> 5;
    LAS float* Ere = (LAS float*)(F.lds + RING_OFF); LAS float* Eim = Ere + 64 * SSM_EP;
    LAS float* ST = (LAS float*)(F.lds + RING_OFF + SSM_ST_OFF);
    LAS v4u* A2T = (LAS v4u*)(F.lds + RING_OFF + SSM_A2T_OFF);
    LAS v4u* A1T = (LAS v4u*)(F.lds + RING_OFF + SSM_A1T_OFF);
    const float* SA = (const float*)(F.ws + WS_SA) + (size_t)g * NST * 8;
    const float* BB = (const float*)(F.ws + WS_BBAR) + (size_t)g * NST * 32;
    const float* Cre = F.in[15] + (size_t)g * NCH * NST; const float* Cim = F.in[16] + (size_t)g * NCH * NST;
    float ar[2][16], ai[2][16];
#pragma unroll
    for (int s = 0; s < 2; ++s)
#pragma unroll
        for (int r = 0; r < 16; ++r) { const int n = 32 * s + (r & 3) + 8 * (r >> 2) + 4 * h; ar[s][r] = SA[n * 8]; ai[s][r] = SA[n * 8 + 1]; }
    if (w < 4) { const int tau = w; const int n = 32 * (tau >> 1) + col; float v[8];
#pragma unroll
        for (int jj = 0; jj < 8; ++jj) { const int ch = 4 * h + (jj & 3) + 8 * (jj >> 2); v[jj] = BB[n * 32 + 2 * ch + (tau & 1)]; }
        A1T[tau * 64 + lane] = __builtin_bit_cast(v4u, pack8(v[0], v[1], v[2], v[3], v[4], v[5], v[6], v[7])); }
    if (w == 4) { float v[8];
#pragma unroll
      for (int jj = 0; jj < 8; ++jj) { const int ch = 4 * h + (jj & 3) + 8 * (jj >> 2); v[jj] = (col < 16 && ch == col) ? F.in[17][g * NCH + col] : 0.f; }
      A1T[4 * 64 + lane] = __builtin_bit_cast(v4u, pack8(v[0], v[1], v[2], v[3], v[4], v[5], v[6], v[7])); }
    { const int tau = w >> 1, s = w & 1; float v[8];
#pragma unroll
      for (int jj = 0; jj < 8; ++jj) { const int n = 32 * (tau >> 1) + 16 * s + 8 * (jj >> 2) + 4 * h + (jj & 3);
          v[jj] = col < 16 ? ((tau & 1) ? -Cim[col * NST + n] : Cre[col * NST + n]) : 0.f; }
      A2T[w * 64 + lane] = __builtin_bit_cast(v4u, pack8(v[0], v[1], v[2], v[3], v[4], v[5], v[6], v[7])); }
    __syncthreads();
#define A1F(k) __builtin_bit_cast(bf16x8, A1T[(k) * 64 + lane])
    const size_t row0 = (size_t)b * SEQ + 32 * (32 * w + col);
    const bf16* Up = (const bf16*)(F.ws + WS_H) + 4 * HREG + row0 * DA + g * NCH + 4 * h;
    bf16* Zp = (bf16*)(F.ws + WS_Z) + row0 * DA + g * NCH + 4 * h;
    typedef unsigned long long u64x2 __attribute__((ext_vector_type(2)));
#define SSM_LOADU(t) ({ u64x2 _q; _q.x = *(const GAS unsigned long long*)(Up + (size_t)(t) * DA); _q.y = *(const GAS unsigned long long*)(Up + (size_t)(t) * DA + 8); __builtin_bit_cast(bf16x8, _q); })
    float xr[2][16], xi[2][16];
#pragma unroll
    for (int s = 0; s < 2; ++s)
#pragma unroll
        for (int r = 0; r < 16; ++r) { xr[s][r] = 0.f; xi[s][r] = 0.f; }
    const f32x16 zero16 = {0.f, 0.f, 0.f, 0.f, 0.f, 0.f, 0.f, 0.f, 0.f, 0.f, 0.f, 0.f, 0.f, 0.f, 0.f, 0.f};
    {
        bf16x8 Bq[2];
#pragma unroll
        for (int j = 0; j < 2; ++j) Bq[j] = SSM_LOADU(j);
#pragma unroll 1
        for (int t4 = 0; t4 < 32; t4 += 2) {
#pragma unroll
            for (int j = 0; j < 2; ++j) {
                asm volatile("" ::: "memory"); __builtin_amdgcn_sched_barrier(0);
                const bf16x8 B1 = Bq[j];
                Bq[j] = SSM_LOADU(t4 + 2 + j < 32 ? t4 + 2 + j : 31);
#pragma unroll
                for (int s = 0; s < 2; ++s) {
                    const f32x16 bre = __builtin_amdgcn_mfma_f32_32x32x16_bf16(A1F(2 * s), B1, zero16, 0, 0, 0);
                    const f32x16 bim = __builtin_amdgcn_mfma_f32_32x32x16_bf16(A1F(2 * s + 1), B1, zero16, 0, 0, 0);
#pragma unroll
                    for (int r = 0; r < 16; ++r) { const float nr = ar[s][r] * xr[s][r] - ai[s][r] * xi[s][r] + bre[r], ni = ar[s][r] * xi[s][r] + ai[s][r] * xr[s][r] + bim[r]; xr[s][r] = nr; xi[s][r] = ni; }
                }
            }
        }
    }
    { const int c = 32 * w + col;
#pragma unroll
      for (int s = 0; s < 2; ++s)
#pragma unroll
          for (int r = 0; r < 16; ++r) { const int n = 32 * s + (r & 3) + 8 * (r >> 2) + 4 * h; Ere[n * SSM_EP + c] = xr[s][r]; Eim[n * SSM_EP + c] = xi[s][r]; } }
    __syncthreads();
    {
        const int n = lane; const float a32r = SA[n * 8 + 2], a32i = SA[n * 8 + 3], a1kr = SA[n * 8 + 4], a1ki = SA[n * 8 + 5];
        float cr = 0.f, ci = 0.f;
#pragma unroll 4
        for (int k = 0; k < 32; ++k) { const int idx = n * SSM_EP + 32 * w + k; const float tr = Ere[idx], ti = Eim[idx]; Ere[idx] = cr; Eim[idx] = ci;
            const float nr = a32r * cr - a32i * ci + tr, ni = a32r * ci + a32i * cr + ti; cr = nr; ci = ni; }
        ST[(w * 64 + n) * 2] = cr; ST[(w * 64 + n) * 2 + 1] = ci;
        __syncthreads();
        float pr = 0.f, pi = 0.f;
        for (int w2 = 0; w2 < w; ++w2) { const float tr = ST[(w2 * 64 + n) * 2], ti = ST[(w2 * 64 + n) * 2 + 1]; const float nr = a1kr * pr - a1ki * pi + tr, ni = a1kr * pi + a1ki * pr + ti; pr = nr; pi = ni; }
#pragma unroll 4
        for (int k = 0; k < 32; ++k) { const int idx = n * SSM_EP + 32 * w + k; Ere[idx] += pr; Eim[idx] += pi; const float nr = a32r * pr - a32i * pi, ni = a32r * pi + a32i * pr; pr = nr; pi = ni; }
    }
    __syncthreads();
    { const int c = 32 * w + col;
#pragma unroll
      for (int s = 0; s < 2; ++s)
#pragma unroll
          for (int r = 0; r < 16; ++r) { const int n = 32 * s + (r & 3) + 8 * (r >> 2) + 4 * h; xr[s][r] = Ere[n * SSM_EP + c]; xi[s][r] = Eim[n * SSM_EP + c]; } }
    {
        bf16x8 Bq[1];
        Bq[0] = SSM_LOADU(0);
#pragma unroll 1
        for (int t4 = 0; t4 < 32; t4 += 1) {
          { const int j = 0;
            asm volatile("" ::: "memory"); __builtin_amdgcn_sched_barrier(0);
            const int t = t4 + j;
            const bf16x8 B1 = Bq[j];
            Bq[j] = SSM_LOADU(t + 1 < 32 ? t + 1 : 31);
            f32x16 Y = __builtin_amdgcn_mfma_f32_32x32x16_bf16(A1F(4), B1, zero16, 0, 0, 0);
#pragma unroll
            for (int s = 0; s < 2; ++s) {
                const f32x16 bre = __builtin_amdgcn_mfma_f32_32x32x16_bf16(A1F(2 * s), B1, zero16, 0, 0, 0);
                const f32x16 bim = __builtin_amdgcn_mfma_f32_32x32x16_bf16(A1F(2 * s + 1), B1, zero16, 0, 0, 0);
#pragma unroll
                for (int r = 0; r < 16; ++r) { const float nr = ar[s][r] * xr[s][r] - ai[s][r] * xi[s][r] + bre[r], ni = ar[s][r] * xi[s][r] + ai[s][r] * xr[s][r] + bim[r]; xr[s][r] = nr; xi[s][r] = ni; }
#pragma unroll
                for (int q = 0; q < 2; ++q) {
                    const bf16x8 fre = pack8(xr[s][8 * q], xr[s][8 * q + 1], xr[s][8 * q + 2], xr[s][8 * q + 3], xr[s][8 * q + 4], xr[s][8 * q + 5], xr[s][8 * q + 6], xr[s][8 * q + 7]);
                    const bf16x8 fim = pack8(xi[s][8 * q], xi[s][8 * q + 1], xi[s][8 * q + 2], xi[s][8 * q + 3], xi[s][8 * q + 4], xi[s][8 * q + 5], xi[s][8 * q + 6], xi[s][8 * q + 7]);
                    const bf16x8 are = __builtin_bit_cast(bf16x8, A2T[(4 * s + q) * 64 + lane]);
                    const bf16x8 aim = __builtin_bit_cast(bf16x8, A2T[(4 * s + 2 + q) * 64 + lane]);
                    Y = __builtin_amdgcn_mfma_f32_32x32x16_bf16(are, fre, Y, 0, 0, 0);
                    Y = __builtin_amdgcn_mfma_f32_32x32x16_bf16(aim, fim, Y, 0, 0, 0);
                }
            }
            const unsigned long long z0 = (unsigned long long)cvtpk(gelu_tanh(Y[0]), gelu_tanh(Y[1])) | ((unsigned long long)cvtpk(gelu_tanh(Y[2]), gelu_tanh(Y[3])) << 32);
            const unsigned long long z1 = (unsigned long long)cvtpk(gelu_tanh(Y[4]), gelu_tanh(Y[5])) | ((unsigned long long)cvtpk(gelu_tanh(Y[6]), gelu_tanh(Y[7])) << 32);
            *(GAS unsigned long long*)(Zp + (size_t)t * DA) = z0; *(GAS unsigned long long*)(Zp + (size_t)t * DA + 8) = z1;
          }
        }
    }
#undef SSM_LOADU
#undef A1F
    if (w == 7 && col == 31) {
        float* outr = F.out + O_SRP + (size_t)(b * NGRP + g) * NST; float* outi = F.out + O_SIP + (size_t)(b * NGRP + g) * NST;
#pragma unroll
        for (int s = 0; s < 2; ++s)
#pragma unroll
            for (int r = 0; r < 16; ++r) { const int n = 32 * s + (r & 3) + 8 * (r >> 2) + 4 * h; outr[n] = xr[s][r]; outi[n] = xi[s][r]; }
    }
    __syncthreads();
}
typedef short v4i16_t __attribute__((ext_vector_type(4)));
constexpr int AT_OST = 0, AT_ML = 65536, AT_TB = 69632, AT_VST = 73728, AT_KST = AT_VST + 8 * 4096, AT_LDS_END = AT_KST + 8 * 4096;
__device__ __forceinline__ float xhalf_max(float v) { auto rr = __builtin_amdgcn_permlane32_swap(__float_as_uint(v), __float_as_uint(v), false, false); return fmaxf(__uint_as_float(rr[0]), __uint_as_float(rr[1])); }
__device__ __forceinline__ float xhalf_sum(float v) { auto rr = __builtin_amdgcn_permlane32_swap(__float_as_uint(v), __float_as_uint(v), false, false); return __uint_as_float(rr[0]) + __uint_as_float(rr[1]); }
template <int VAR>
__device__ __forceinline__ void attn_fast_unit(Frame& F, int b, int h, int wi, bf16* BRout) {
    const int lane = F.lane, w = F.wave, qi = lane & 31, hh = lane >> 5;
    LAS unsigned long long* OST = (LAS unsigned long long*)(F.lds + RING_OFF + AT_OST);
    LAS float* ML = (LAS float*)(F.lds + RING_OFF + AT_ML);
    LAS float* TB = (LAS float*)(F.lds + RING_OFF + AT_TB);
    LAS unsigned char* VST = F.lds + RING_OFF + AT_VST + w * 4096;
    LAS unsigned char* KST = F.lds + RING_OFF + AT_KST + w * 4096;
    for (int e = F.tid; e < 4 * 192; e += NWAVES * 64) { const int p = e / 192, y = e - p * 192, rel = 159 - y;
        TB[e] = (p < 3 && rel >= 0 && rel <= 128) ? F.in[9][t5_bucket(rel << (2 * p)) * NHEAD + h] * 1.4426950408889634f : -1e30f; }
    __syncthreads();
    const bf16* Hb = (const bf16*)(F.ws + WS_H);
    const bf16* Qb = Hb + h * HD; const bf16* Kb = Hb + HREG + h * HD; const bf16* Vb = Hb + 2 * HREG + h * HD; const bf16* Gb = Hb + 3 * HREG + h * HD;
    bf16* BR = BRout + h * HD;
    const size_t rowbase = (size_t)b * SEQ; const int P0 = 512 * wi;
    const int vdst0 = ((lane & 7) >> 2) * 512 + (lane >> 3) * 64 + (lane & 3) * 16;
    const int trb = (4 * hh + ((lane >> 2) & 3)) * 64 + (16 * ((lane >> 4) & 1) + 4 * (lane & 3)) * 2;
#define AT_GEOM(p_, qq_, SH, R, TI, TMAX) const int SH = 2 * (p_), R = (2 * w + (qq_)) >> (4 - SH), TI = (2 * w + (qq_)) & ((1 << (4 - SH)) - 1), TMAX = min(4, TI + (P0 >> (SH + 5)))
#define AT_KBASE(p_, qq_, tp_) AT_GEOM(p_, qq_, sh_, r_, ti_, tmax_); const int tpc_ = min((int)(tp_), tmax_); const size_t kbase_ = rowbase + r_ + ((size_t)((P0 >> sh_) + 32 * (ti_ - tpc_)) << sh_)
#define AT_LOADK(KR, p_, qq_, tp_) do { if (VAR == 1) break; AT_KBASE(p_, qq_, tp_); const unsigned vo_ = ((((unsigned)(lane >> 3) << sh_) * DA) + 8 * (lane & 7)) * 2u; \
        _Pragma("unroll") for (int i = 0; i < 4; ++i) { const char* kub_ = (const char*)(Kb + (kbase_ + ((size_t)(8 * i) << sh_)) * DA); KR[i] = *(const v4u*)(kub_ + vo_); } } while (0)
#define AT_LOADV(VR, p_, qq_, tp_) do { if (VAR == 1) break; AT_KBASE(p_, qq_, tp_); const unsigned vo_ = ((((unsigned)(lane >> 3) << sh_) * DA) + 8 * (lane & 7)) * 2u; \
        _Pragma("unroll") for (int i = 0; i < 4; ++i) { const char* vub_ = (const char*)(Vb + (kbase_ + ((size_t)(8 * i) << sh_)) * DA); VR[i] = *(const v4u*)(vub_ + vo_); } } while (0)
#define AT_LOADQ(QF, p_, qq_) do { AT_GEOM(p_, qq_, sh_, r_, ti_, tmax_); (void)tmax_; const size_t pq_ = rowbase + P0 + r_ + ((size_t)(32 * ti_ + qi) << sh_); \
        _Pragma("unroll") for (int ks = 0; ks < 4; ++ks) QF[ks] = *(const bf16x8*)(Qb + pq_ * DA + 16 * ks + 8 * hh); } while (0)
#define AT_VTR(off) __builtin_bit_cast(v4i16_t, __builtin_amdgcn_ds_read_tr16_b64_v4i16((LAS v4i16_t*)(VST + trb + (off))))
#define AT_VT(s2, dt) ({ const v4i16_t _a = AT_VTR((4 * (s2) + (dt)) * 512), _b = AT_VTR((4 * (s2) + 2 + (dt)) * 512); (bf16x8){_a[0], _a[1], _a[2], _a[3], _b[0], _b[1], _b[2], _b[3]}; })
    bf16x8 qf[4]; v4u krA[4], krB[4], vr[4];
    const int kdst0 = (lane >> 3) * 128 + (((lane & 7) ^ ((lane >> 4) & 7)) * 16);
    const int ksrc0 = qi * 128;
    if (VAR == 1) { _Pragma("unroll") for (int i = 0; i < 4; ++i) { krA[i] = (v4u){1u, 2u, 3u, 4u}; krB[i] = krA[i]; vr[i] = krA[i]; } asm volatile("" : "+v"(krA[0]), "+v"(krB[0]), "+v"(vr[0])); }
    f32x16 O0, O1; float m = -1e30f, l = 0.f;
    AT_LOADQ(qf, 0, 0);
    AT_LOADK(krA, 0, 0, 0); AT_LOADV(vr, 0, 0, 0); AT_LOADK(krB, 0, 0, 1);
#define AT_KSTAGE(KR) do { _Pragma("unroll") for (int i = 0; i < 4; ++i) *(LAS v4u*)(KST + (kdst0 ^ ((i & 1) * 64)) + 1024 * i) = KR[i]; } while (0)
    AT_KSTAGE(krA);
    AT_LOADK(krA, 0, 0, 2);
#define AT_QBEGIN(qq_) do { AT_GEOM(p, qq_, sh_, r_, ti_, tmax_); (void)tmax_; const int qloc_ = r_ + ((32 * ti_ + qi) << sh_), slot_ = qloc_ ^ ((qloc_ >> 5) & 15); \
        if (p == 0) { _Pragma("unroll") for (int r2 = 0; r2 < 16; ++r2) { O0[r2] = 0.f; O1[r2] = 0.f; } m = -1e30f; l = 0.f; } \
        else { _Pragma("unroll") for (int k = 0; k < 4; ++k) { \
                const unsigned long long a = OST[(2 * k + hh) * 512 + slot_], c = OST[(8 + 2 * k + hh) * 512 + slot_]; \
                O0[4 * k] = __builtin_bit_cast(float, (unsigned)a << 16); O0[4 * k + 1] = __builtin_bit_cast(float, (unsigned)a & 0xffff0000u); \
                O0[4 * k + 2] = __builtin_bit_cast(float, (unsigned)(a >> 32) << 16); O0[4 * k + 3] = __builtin_bit_cast(float, (unsigned)(a >> 32) & 0xffff0000u); \
                O1[4 * k] = __builtin_bit_cast(float, (unsigned)c << 16); O1[4 * k + 1] = __builtin_bit_cast(float, (unsigned)c & 0xffff0000u); \
                O1[4 * k + 2] = __builtin_bit_cast(float, (unsigned)(c >> 32) << 16); O1[4 * k + 3] = __builtin_bit_cast(float, (unsigned)(c >> 32) & 0xffff0000u); } \
            m = ML[slot_ * 2]; l = hh == 0 ? ML[slot_ * 2 + 1] : 0.f; } } while (0)
#define AT_QEND(qq_) do { AT_GEOM(p, qq_, sh_, r_, ti_, tmax_); (void)tmax_; const int qloc_ = r_ + ((32 * ti_ + qi) << sh_), slot_ = qloc_ ^ ((qloc_ >> 5) & 15); \
        const float lt_ = xhalf_sum(l); \
        if (p < 2) { _Pragma("unroll") for (int k = 0; k < 4; ++k) { \
                OST[(2 * k + hh) * 512 + slot_] = (unsigned long long)cvtpk(O0[4 * k], O0[4 * k + 1]) | ((unsigned long long)cvtpk(O0[4 * k + 2], O0[4 * k + 3]) << 32); \
                OST[(8 + 2 * k + hh) * 512 + slot_] = (unsigned long long)cvtpk(O1[4 * k], O1[4 * k + 1]) | ((unsigned long long)cvtpk(O1[4 * k + 2], O1[4 * k + 3]) << 32); } \
            if (hh == 0) { ML[slot_ * 2] = m; ML[slot_ * 2 + 1] = lt_; } } \
        else { const float inv_ = 1.0f / lt_; const size_t pq_ = rowbase + P0 + qloc_; \
            _Pragma("unroll") for (int k = 0; k < 4; ++k) { _Pragma("unroll") for (int dt = 0; dt < 2; ++dt) { \
                const unsigned long long gw = *(const GAS unsigned long long*)(Gb + pq_ * DA + 32 * dt + 8 * k + 4 * hh); \
                const float g0 = __builtin_bit_cast(float, (unsigned)gw << 16), g1 = __builtin_bit_cast(float, (unsigned)gw & 0xffff0000u); \
                const float g2 = __builtin_bit_cast(float, (unsigned)(gw >> 32) << 16), g3 = __builtin_bit_cast(float, (unsigned)(gw >> 32) & 0xffff0000u); \
                const float o0 = (dt ? O1[4 * k] : O0[4 * k]) * inv_ * g0, o1 = (dt ? O1[4 * k + 1] : O0[4 * k + 1]) * inv_ * g1; \
                const float o2 = (dt ? O1[4 * k + 2] : O0[4 * k + 2]) * inv_ * g2, o3 = (dt ? O1[4 * k + 3] : O0[4 * k + 3]) * inv_ * g3; \
                *(GAS unsigned long long*)(BR + pq_ * 2048 + 32 * dt + 8 * k + 4 * hh) = (unsigned long long)cvtpk(o0, o1) | ((unsigned long long)cvtpk(o2, o3) << 32); } } } } while (0)
#define AT_STEP(KRN, s_) do { const int sq_ = (s_) >= 5 ? 1 : 0, tp = (s_) - 5 * sq_; AT_GEOM(p, sq_, shc_, rc_, tic_, tmaxc_); (void)rc_; (void)tic_; (void)shc_; \
        f32x16 S; \
        { const LAS float* tb = TB + (tp <= tmaxc_ ? p : 3) * 192 + (159 - 32 * tp - qi + 4 * hh); \
          _Pragma("unroll") for (int r2 = 0; r2 < 16; ++r2) S[r2] = VAR == 2 ? 0.f : tb[(r2 & 3) + 8 * (r2 >> 2)]; } \
        _Pragma("unroll") for (int ks = 0; ks < 4; ++ks) { const bf16x8 kf_ = *(const LAS bf16x8*)(KST + ksrc0 + (((2 * ks + hh) ^ ((qi >> 1) & 7)) * 16)); \
            S = __builtin_amdgcn_mfma_f32_32x32x16_bf16(kf_, qf[ks], S, 0, 0, 0); } \
        __builtin_amdgcn_sched_barrier(0); \
        if (tp == 4) { if (sq_ == 0) AT_LOADQ(qf, p, 1); else AT_LOADQ(qf, pn, 0); } \
        __builtin_amdgcn_sched_barrier(0); \
        float mx = fmaxf(fmaxf(S[0], S[1]), fmaxf(S[2], S[3])); \
        _Pragma("unroll") for (int r2 = 4; r2 < 16; r2 += 4) mx = fmaxf(mx, fmaxf(fmaxf(S[r2], S[r2 + 1]), fmaxf(S[r2 + 2], S[r2 + 3]))); \
        mx = xhalf_max(mx); \
        const float mn = fmaxf(m, mx), alpha = __builtin_amdgcn_exp2f(m - mn); \
        m = mn; \
        float ps = 0.f; \
        _Pragma("unroll") for (int r2 = 0; r2 < 16; ++r2) { S[r2] = VAR == 4 ? S[r2] - mn : __builtin_amdgcn_exp2f(S[r2] - mn); ps += S[r2]; } \
        l = l * alpha + ps; \
        _Pragma("unroll") for (int r2 = 0; r2 < 16; ++r2) { O0[r2] *= alpha; O1[r2] *= alpha; } \
        const bf16x8 pf0 = pack8(S[0], S[1], S[2], S[3], S[4], S[5], S[6], S[7]); \
        const bf16x8 pf1 = pack8(S[8], S[9], S[10], S[11], S[12], S[13], S[14], S[15]); \
        if (VAR != 3) { _Pragma("unroll") for (int i = 0; i < 4; ++i) *(LAS v4u*)(VST + vdst0 + 1024 * i) = vr[i]; } \
        AT_KSTAGE(KRN); \
        __builtin_amdgcn_sched_barrier(0); \
        { const int s1_ = (s_) + 1, np_ = s1_ >= 10 ? pn : p, sn_ = s1_ >= 10 ? s1_ - 10 : s1_, nq_ = sn_ >= 5 ? 1 : 0; \
          AT_LOADV(vr, np_, nq_, sn_ - 5 * nq_); } \
        { const int s3_ = (s_) + 3, np_ = s3_ >= 10 ? pn : p, sn_ = s3_ >= 10 ? s3_ - 10 : s3_, nq_ = sn_ >= 5 ? 1 : 0; \
          AT_LOADK(KRN, np_, nq_, sn_ - 5 * nq_); } \
        __builtin_amdgcn_sched_barrier(0); \
        { const bf16x8 v00 = VAR == 3 ? __builtin_bit_cast(bf16x8, vr[0]) : AT_VT(0, 0), v10 = VAR == 3 ? __builtin_bit_cast(bf16x8, vr[1]) : AT_VT(1, 0), v01 = VAR == 3 ? __builtin_bit_cast(bf16x8, vr[2]) : AT_VT(0, 1), v11 = VAR == 3 ? __builtin_bit_cast(bf16x8, vr[3]) : AT_VT(1, 1); \
          O0 = __builtin_amdgcn_mfma_f32_32x32x16_bf16(v00, pf0, O0, 0, 0, 0); O0 = __builtin_amdgcn_mfma_f32_32x32x16_bf16(v10, pf1, O0, 0, 0, 0); \
          O1 = __builtin_amdgcn_mfma_f32_32x32x16_bf16(v01, pf0, O1, 0, 0, 0); O1 = __builtin_amdgcn_mfma_f32_32x32x16_bf16(v11, pf1, O1, 0, 0, 0); } \
    } while (0)
#pragma unroll 1
    for (int p = 0; p < 3; ++p) {
        const int pn = p < 2 ? p + 1 : 2;
        AT_QBEGIN(0);
#pragma unroll 1
        for (int sp = 0; sp < 5; ++sp) {
            AT_STEP(krB, 2 * sp);
            if (sp == 2) { AT_QEND(0); AT_QBEGIN(1); }
            AT_STEP(krA, 2 * sp + 1);
        }
        AT_QEND(1);
        __syncthreads();
    }
#undef AT_STEP
#undef AT_KSTAGE
#undef AT_QEND
#undef AT_QBEGIN
#undef AT_VT
#undef AT_VTR
#undef AT_LOADQ
#undef AT_LOADV
#undef AT_LOADK
#undef AT_KBASE
#undef AT_GEOM
}
typedef float f32x4_t __attribute__((ext_vector_type(4)));
template <class Epi>
__device__ __forceinline__ void small_gemm_item(Frame& F, const bf16* A, int lda, const bf16* Bt, int K, int n0, const Epi& E) {
    const int lane = F.lane, w = F.wave, m = lane & 15, q = lane >> 4;
    const bf16* ap = A + (size_t)(16 * w + m) * lda + 8 * q;
    const bf16* bp0 = Bt + (size_t)(n0 + m) * K + 8 * q; const bf16* bp1 = bp0 + (size_t)16 * K;
    f32x4_t acc0 = {0.f, 0.f, 0.f, 0.f}, acc1 = {0.f, 0.f, 0.f, 0.f};
#pragma unroll 8
    for (int k = 0; k < K; k += 32) {
        const bf16x8 a = *(const bf16x8*)(ap + k), b0 = *(const bf16x8*)(bp0 + k), b1 = *(const bf16x8*)(bp1 + k);
        acc0 = __builtin_amdgcn_mfma_f32_16x16x32_bf16(b0, a, acc0, 0, 0, 0);
        acc1 = __builtin_amdgcn_mfma_f32_16x16x32_bf16(b1, a, acc1, 0, 0, 0);
    }
    E(16 * w + m, n0 + 4 * q, acc0); E(16 * w + m, n0 + 16 + 4 * q, acc1);
}
struct SEpiIn { bf16* H; float* ks; float* vs;
    __device__ __forceinline__ void operator()(int row, int col, f32x4_t v) const {
        const int region = col >> 10, c = col & 1023;
        if (region == 0) v = v * pg8::QSCALE;
        if (region == 3 || region == 5) { v[0] = pg8::silu_f(v[0]); v[1] = pg8::silu_f(v[1]); v[2] = pg8::silu_f(v[2]); v[3] = pg8::silu_f(v[3]); }
        *(unsigned long long*)(H + (size_t)region * HREG + (size_t)(M_P + row) * DA + c) = (unsigned long long)cvtpk(v[0], v[1]) | ((unsigned long long)cvtpk(v[2], v[3]) << 32);
        if (region == 1) *(f32x4_t*)(ks + (size_t)row * DA + c) = v;
        if (region == 2) *(f32x4_t*)(vs + (size_t)row * DA + c) = v;
    } };
struct SEpiGlu { const bf16* Z; const bf16* GS; const float* bias; bf16* BR;
    __device__ __forceinline__ void operator()(int row, int col, f32x4_t v) const {
        const size_t r = (size_t)(M_P + row);
        const unsigned long long zw = *(const unsigned long long*)(Z + r * DA + col), gw = *(const unsigned long long*)(GS + r * DA + col);
        const f32x4_t bv = *(const f32x4_t*)(bias + col); float o[4];
#pragma unroll
        for (int e = 0; e < 4; ++e) { const unsigned zz = (unsigned)(zw >> (32 * (e >> 1))), gg = (unsigned)(gw >> (32 * (e >> 1)));
            const float zf = __builtin_bit_cast(float, (e & 1) ? (zz & 0xffff0000u) : (zz << 16)), gf = __builtin_bit_cast(float, (e & 1) ? (gg & 0xffff0000u) : (gg << 16));
            o[e] = zf * __builtin_amdgcn_rcpf(1.0f + __expf(-(v[e] + bv[e]))) * gf; }
        *(unsigned long long*)(BR + r * 2048 + 1024 + col) = (unsigned long long)cvtpk(o[0], o[1]) | ((unsigned long long)cvtpk(o[2], o[3]) << 32);
    } };
struct SEpiOut { const float* xs; const float* bias; float* ys; float alpha;
    __device__ __forceinline__ void operator()(int row, int col, f32x4_t v) const {
        const f32x4_t xv = *(const f32x4_t*)(xs + (size_t)row * DM + col), bv = *(const f32x4_t*)(bias + col);
        *(f32x4_t*)(ys + (size_t)row * DM + col) = v + bv + xv * alpha;
    } };
constexpr int SA_LG = 0, SA_PART = 8192, SA_LDS_END = SA_PART + 8 * 4 * 66 * 4;
__device__ __forceinline__ void sample_attn_task(Frame& F, int db, int h, const LAS int* bkt) {
    const int lane = F.lane, w = F.wave, s = lane >> 4, li = lane & 15;
    const bf16* Hq = (const bf16*)(F.ws + WS_H);
    const size_t qrow = (size_t)(M_P + db * 4 + s);
    float q4[4];
    { const unsigned long long qw = *(const GAS unsigned long long*)(Hq + qrow * DA + h * HD + 4 * li);
      q4[0] = __builtin_bit_cast(float, (unsigned)qw << 16); q4[1] = __builtin_bit_cast(float, (unsigned)qw & 0xffff0000u);
      q4[2] = __builtin_bit_cast(float, (unsigned)(qw >> 32) << 16); q4[3] = __builtin_bit_cast(float, (unsigned)(qw >> 32) & 0xffff0000u); }
    const float* ck = F.in[2] + ((size_t)db * 2048 * NHEAD + h) * HD + 4 * li; const float* cv = F.in[3] + ((size_t)db * 2048 * NHEAD + h) * HD + 4 * li;
    const float* kn = F.out + O_KS + (size_t)(db * 4) * DA + h * HD + 4 * li; const float* vn = F.out + O_VS + (size_t)(db * 4) * DA + h * HD + 4 * li;
    LAS float* lg = (LAS float*)(F.lds + RING_OFF + SA_LG) + (w * 4 + s) * 64;
    const int e0 = 49 * w, ne = min(49, 387 - e0);
#define SA_ROW(base_c, base_n, e_) ({ const int p_ = (e_) / 129, j_ = (e_) - p_ * 129, idx_ = 2048 + s - (j_ << (2 * p_)); \
        idx_ < 2048 ? (base_c) + (size_t)idx_ * (NHEAD * HD) : (base_n) + (size_t)(idx_ - 2048) * DA; })
    float mx = -1e30f;
#pragma unroll 1
    for (int i0 = 0; i0 < 49; i0 += 7) {
        f32x4 kv[7];
#pragma unroll
        for (int i = 0; i < 7; ++i) { const int e = e0 + min(i0 + i, ne - 1); kv[i] = *(const f32x4*)SA_ROW(ck, kn, e); }
#pragma unroll
        for (int i = 0; i < 7; ++i) {
            float d = kv[i].x * q4[0] + kv[i].y * q4[1] + kv[i].z * q4[2] + kv[i].w * q4[3];
            d += __shfl_xor(d, 1); d += __shfl_xor(d, 2); d += __shfl_xor(d, 4); d += __shfl_xor(d, 8);
            const int e = e0 + min(i0 + i, ne - 1);
            d += F.in[9][bkt[e] * NHEAD + h] * 1.4426950408889634f;
            if (i0 + i < ne) { mx = fmaxf(mx, d); if (li == 0) lg[i0 + i] = d; }
        }
    }
    LDS_WAIT(); asm volatile("" ::: "memory");
    float o4[4] = {0.f, 0.f, 0.f, 0.f}, l = 0.f;
#pragma unroll 1
    for (int i0 = 0; i0 < 49; i0 += 7) {
        f32x4 vv[7];
#pragma unroll
        for (int i = 0; i < 7; ++i) { const int e = e0 + min(i0 + i, ne - 1); vv[i] = *(const f32x4*)SA_ROW(cv, vn, e); }
#pragma unroll
        for (int i = 0; i < 7; ++i) {
            const float pe = (i0 + i < ne) ? exp2f(lg[i0 + i] - mx) : 0.f;
            l += pe; o4[0] += pe * vv[i].x; o4[1] += pe * vv[i].y; o4[2] += pe * vv[i].z; o4[3] += pe * vv[i].w;
        }
    }
#undef SA_ROW
    LAS float* part = (LAS float*)(F.lds + RING_OFF + SA_PART) + (w * 4 + s) * 66;
    part[4 * li] = o4[0]; part[4 * li + 1] = o4[1]; part[4 * li + 2] = o4[2]; part[4 * li + 3] = o4[3];
    if (li == 0) { part[64] = mx; part[65] = l; }
    __syncthreads();
    if (w < 4) {
        const LAS float* pp = (const LAS float*)(F.lds + RING_OFF + SA_PART) + w * 66;
        float M = -1e30f;
#pragma unroll
        for (int k = 0; k < 8; ++k) M = fmaxf(M, pp[k * 4 * 66 + 64]);
        float num = 0.f, den = 0.f;
#pragma unroll
        for (int k = 0; k < 8; ++k) { const float f = exp2f(pp[k * 4 * 66 + 64] - M); num += f * pp[k * 4 * 66 + lane]; den += f * pp[k * 4 * 66 + 65]; }
        const size_t orow = (size_t)(M_P + db * 4 + w);
        const float ga = bf2f(Hq[3 * HREG + orow * DA + h * HD + lane]);
        ((bf16*)(F.ws + WS_BR))[orow * 2048 + h * HD + lane] = (bf16)f2bf(num / den * ga);
    }
    __syncthreads();
}
#ifndef REP_PHASE
#define REP_PHASE -1
#endif
#ifndef REP_SUB
#define REP_SUB 0
#endif
#ifndef MK_N_LAUNCHES
#define MK_N_LAUNCHES 1
#endif
constexpr int N_PHASES = 6;
constexpr int N_LAUNCHES = MK_N_LAUNCHES;
struct Args { const float* in[22]; float* out; unsigned char* ws; int ph_lo, ph_hi, li, pad; };
__global__ void __launch_bounds__(NWAVES * 64, 2) fwd_kernel(Args args) {
    extern __shared__ __attribute__((aligned(16))) unsigned char lds[];
    Frame F;
    F.lds = (LAS unsigned char*)lds;
    F.MISC = (volatile LAS unsigned*)(F.lds + MISC_OFF);
    F.tid = threadIdx.x; F.lane = F.tid & 63; F.wave = __builtin_amdgcn_readfirstlane(F.tid >> 6);
    F.G = gridDim.x; { const int bx = blockIdx.x; F.vcu = (F.G % 8 == 0) ? (bx % 8) * (F.G / 8) + bx / 8 : bx; }
    F.ws = args.ws; F.out = args.out;
#pragma unroll
    for (int i = 0; i < 22; ++i) F.in[i] = args.in[i];
    F.ctl = (gu32*)(F.ws + WS_CTL);
    for (int u = F.tid; u < (LDS_BYTES - LDSCTL_OFF) / 4; u += NWAVES * 64) ((LAS unsigned*)(F.lds + LDSCTL_OFF))[u] = 0u;
    __syncthreads();
    XcdBarrier bar; bar.bar = (unsigned*)(F.ctl + CW_BAR); bar.x = 0; bar.st = nullptr;
    if (N_LAUNCHES == 1) bar = xcd_barrier_post((unsigned*)(F.ctl + CW_BAR), F.MISC + 8);
    const int lo = args.ph_lo, hi = args.ph_hi;
#ifdef DBG_TS
#define STAMP(i) do { if (blockIdx.x == 0 && F.tid == 0) ((unsigned long long*)(F.ws + WS_END))[i] = rt(); } while (0)
    STAMP(0);
#else
#define STAMP(i) do {} while (0)
#endif
#define IN(k) (lo <= (k) && (k) < hi)
#define BOTH(k) (IN(k) && IN((k) + 1))
#define GRID_BAR() do { if (N_LAUNCHES == 1) xcd_barrier(bar); } while (0)

    if (IN(0)) { p0_prologue(F); if (BOTH(0)) GRID_BAR(); STAMP(1); }
    if (IN(1)) {
        pg8::Gemm g{(const pg8::bf16_t*)(F.ws + WS_XB), (const pg8::bf16_t*)(F.ws + WS_WIN), M_P, NPROJ, DM};
        pg8::StaticOrder S; S.init(M_P, NPROJ, F.G, (int)blockIdx.x);
        pg8::EpiIn E{(pg8::bf16_t*)(F.ws + WS_H), F.out + O_KP, F.out + O_VP, F.out + O_KS, F.out + O_VS};
        if (!(args.pad & 2)) pg8::gemm_phase<pg8::EpiIn, pg8::StaticOrder, true, true>(F.lds + RING_OFF, g, S, E);
        { const SEpiIn SE{(bf16*)(F.ws + WS_H), F.out + O_KS, F.out + O_VS};
          if (!(args.pad & 1)) for (int it = F.vcu; it < NPROJ / 32; it += F.G) small_gemm_item(F, (const bf16*)(F.ws + WS_XB) + (size_t)M_P * DM, DM, (const bf16*)(F.ws + WS_WIN), DM, 32 * it, SE); }
        if (BOTH(1)) GRID_BAR();
        STAMP(2);
    }

    if (IN(2)) {
        const int sub = args.pad ? args.pad : 7;
        LAS int* bkt = (LAS int*)(F.lds + RING_OFF + 49152);
        const int gw = (F.vcu >> 1) * NWAVES + F.wave, NGW = (F.G >> 1) * NWAVES;
        if (F.vcu & 1) { if ((sub & 1) && (F.vcu >> 1) < 2 * NGRP) ssm_fast_block(F, (F.vcu >> 1) >> 6, (F.vcu >> 1) & 63); }
        else if (sub & 2) {
            for (int e = F.tid; e < 387; e += NWAVES * 64) { const int p = e / 129, j = e - p * 129; bkt[e] = t5_bucket(j << (2 * p)); }
            __syncthreads();
            for (int task = gw; task < 32 * NGRP; task += NGW) { const int db = task >> 6, g = task & 63;
                ssm_seq(F, g, (size_t)M_P + db * 4, 4, F.in[4] + (size_t)task * NST, F.in[5] + (size_t)task * NST, F.out + O_SRS + (size_t)task * NST, F.out + O_SIS + (size_t)task * NST, (bf16*)(F.ws + WS_Z)); }
            for (int task = F.vcu >> 1; task < 32 * NHEAD; task += (F.G >> 1)) sample_attn_task(F, task >> 4, task & 15, bkt);
        }
        if (sub & 4) {
            const unsigned xq = xb_xcc_id() & 7u; gu32* qbase = F.ctl + CW_Q + (args.pad ? 1024 : 0);
            for (unsigned qk = 0; qk < 8u; ++qk) {
                const unsigned qx = (xq + qk) & 7u;
                for (;;) {
                    __syncthreads();
                    if (F.tid == 0) F.MISC[0] = __hip_atomic_fetch_add(qbase + 64 * qx, 1u, RLX_AGENT);
                    __syncthreads();
                    const unsigned qn = F.MISC[0];
                    if (qn >= 64u) break;
                    const int u = (int)(qx * 64u + qn);
                    attn_fast_unit<0>(F, u >> 8, (u >> 4) & 15, u & 15, (bf16*)(F.ws + WS_BR));
                }
            }
        }
#ifdef ATT_PROBE
        if (sub & 8) for (int u = F.vcu; u < 512; u += F.G) attn_fast_unit<ATT_PROBE>(F, u >> 8, (u >> 4) & 15, u & 15, (bf16*)(F.ws + WS_END));
#endif
#ifdef DBG_SSM
        GRID_BAR();
        if (F.wave == 0 && F.vcu < 2) { const int b = F.vcu, g = F.vcu ? 40 : 3; bf16* Z2 = (bf16*)(F.ws + WS_END); float* scr = (float*)(F.ws + WS_END + 64 * MiB);
            ssm_seq(F, g, (size_t)b * SEQ, SEQ, nullptr, nullptr, scr + F.vcu * 128, scr + F.vcu * 128 + 64, Z2);
            VM_WAIT();
            float dd = 0.f, mm = 0.f;
            for (int t = F.lane; t < SEQ * 16; t += 64) { const size_t idx = ((size_t)b * SEQ + (t >> 4)) * DA + g * NCH + (t & 15);
                const float a = bf2f(((const bf16*)(F.ws + WS_Z))[idx]), r = bf2f(Z2[idx]); dd = fmaxf(dd, fabsf(a - r)); mm = fmaxf(mm, fabsf(r)); }
#pragma unroll
            for (int o = 1; o < 64; o <<= 1) { dd = fmaxf(dd, __shfl_xor(dd, o)); mm = fmaxf(mm, __shfl_xor(mm, o)); }
            if (F.lane == 0) { atomicMax((unsigned*)(F.ctl + CW_Q), __float_as_uint(dd)); atomicMax((unsigned*)(F.ctl + CW_Q + 64), __float_as_uint(mm)); } }
#endif
#ifdef DBG_ATTN
        GRID_BAR();
        { bf16* BR2 = (bf16*)(F.ws + WS_END);
          for (int e = F.tid; e < 387; e += NWAVES * 64) { const int p = e / 129, j = e - p * 129, d = p == 0 ? 1 : (p == 1 ? 4 : 16); bkt[e] = t5_bucket(j * d); }
          __syncthreads();
          for (int k = gw; k < 168 * NHEAD; k += NGW) { const int m = (k >> 4) * 97 + ((k >> 4) < 8 ? 0 : 5), task = m * 16 + (k & 15);
              attn_simple_task<false>(F, task, bkt, BR2);
              const float a = bf2f(((const bf16*)(F.ws + WS_BR))[(size_t)m * 2048 + (k & 15) * HD + F.lane]), r = bf2f(BR2[(size_t)m * 2048 + (k & 15) * HD + F.lane]);
              float dd = fabsf(a - r), mm = fabsf(r);
#pragma unroll
              for (int o = 1; o < 64; o <<= 1) { dd = fmaxf(dd, __shfl_xor(dd, o)); mm = fmaxf(mm, __shfl_xor(mm, o)); }
              if (F.lane == 0) { atomicMax((unsigned*)(F.ctl + CW_Q), __float_as_uint(dd)); atomicMax((unsigned*)(F.ctl + CW_Q + 64), __float_as_uint(mm)); } } }
#endif
        if (BOTH(2)) GRID_BAR();
        STAMP(3);
    }
    if (IN(3)) {
        pg8::Gemm g{(const pg8::bf16_t*)(F.ws + WS_Z), (const pg8::bf16_t*)(F.ws + WS_WGLU), M_P, 1024, 1024};
        pg8::StaticOrder S; S.init(M_P, 1024, F.G, (int)blockIdx.x);
        pg8::EpiGlu E{(const pg8::bf16_t*)(F.ws + WS_Z), (const pg8::bf16_t*)(F.ws + WS_H) + 5 * HREG, F.in[19], (pg8::bf16_t*)(F.ws + WS_BR)};
        if (!(args.pad & 2)) pg8::gemm_phase<pg8::EpiGlu, pg8::StaticOrder, true, true>(F.lds + RING_OFF, g, S, E);
        { const SEpiGlu SE{(const bf16*)(F.ws + WS_Z), (const bf16*)(F.ws + WS_H) + 5 * HREG, F.in[19], (bf16*)(F.ws + WS_BR)};
          if (!(args.pad & 1)) for (int it = F.G - 1 - F.vcu; it < 1024 / 32; it += F.G) small_gemm_item(F, (const bf16*)(F.ws + WS_Z) + (size_t)M_P * DA, DA, (const bf16*)(F.ws + WS_WGLU), 1024, 32 * it, SE); }
        if (BOTH(3)) GRID_BAR();
        STAMP(4);
    }
    if (IN(4)) {
        pg8::Gemm g{(const pg8::bf16_t*)(F.ws + WS_BR), (const pg8::bf16_t*)(F.ws + WS_WOUT), M_P, DM, DM};
        pg8::StaticOrder S; S.init(M_P, DM, F.G, (int)blockIdx.x);
        pg8::EpiOut E{F.in[0], F.in[1], F.in[8], F.out + O_YP, F.out + O_YS, DN_ALPHA};
        if (!(args.pad & 2)) pg8::gemm_phase<pg8::EpiOut, pg8::StaticOrder, true, true>(F.lds + RING_OFF, g, S, E);
        { const SEpiOut SE{F.in[1], F.in[8], F.out + O_YS, DN_ALPHA};
          if (!(args.pad & 1)) for (int it = F.G - 1 - F.vcu; it < DM / 32; it += F.G) small_gemm_item(F, (const bf16*)(F.ws + WS_BR) + (size_t)M_P * DM, DM, (const bf16*)(F.ws + WS_WOUT), DM, 32 * it, SE); }
        if (BOTH(4)) GRID_BAR();
        STAMP(5);
    }
    if (IN(5)) {
        const int gw = F.vcu * NWAVES + F.wave, NGW = F.G * NWAVES;
        for (int m = gw; m < M_TOT; m += NGW) ln_row_inplace(F, m < M_P ? F.out + O_YP + (size_t)m * DM : F.out + O_YS + (size_t)(m - M_P) * DM);
#ifdef DBG_TS
        GRID_BAR(); STAMP(6);
        if (blockIdx.x == 0 && F.tid == 0) { const unsigned long long* ts = (const unsigned long long*)(F.ws + WS_END);
            const float t1 = (float)(ts[DBG_TS_A + 1] - ts[DBG_TS_A]) * 0.01f, t2 = (float)(ts[DBG_TS_B + 1] - ts[DBG_TS_B]) * 0.01f;
            F.out[O_YP] = 1000.f * t1; for (int i = 0; i < 1024; ++i) F.out[O_YS + i] = 50.f * t2; }
#endif
#if defined(DBG_ATTN) || defined(DBG_SSM)
        GRID_BAR();
        if (blockIdx.x == 0 && F.tid == 0) { const float dd = __uint_as_float(__hip_atomic_load(F.ctl + CW_Q, RLX_AGENT)), mm = __uint_as_float(__hip_atomic_load(F.ctl + CW_Q + 64, RLX_AGENT));
            F.out[O_YP] = 1e5f * dd / mm; }
#endif
    }
#undef IN
#undef BOTH
}

extern "C" void kernel_launch(void* const* d_in, const int* in_sizes, int n_in, void* d_out, int out_size, void* d_ws, size_t ws_size, hipStream_t stream) {
    static int grid = 0;
    if (grid == 0) {
        if (n_in != 22 || (size_t)out_size != O_TOTAL || ws_size < WS_END) { fprintf(stderr, "kernel_launch: unexpected shapes: n_in %d out %d ws %zu\n", n_in, out_size, ws_size); grid = -1; return; }
        int dev = 0, cus = 0, per_cu = 0;
        if (hipGetDevice(&dev) != hipSuccess || hipDeviceGetAttribute(&cus, hipDeviceAttributeMultiprocessorCount, dev) != hipSuccess) { grid = -1; return; }
        if (hipFuncSetAttribute((const void*)fwd_kernel, hipFuncAttributeMaxDynamicSharedMemorySize, LDS_BYTES) != hipSuccess) { fprintf(stderr, "kernel_launch: hipFuncSetAttribute failed\n"); grid = -1; return; }
        if (hipOccupancyMaxActiveBlocksPerMultiprocessor(&per_cu, (const void*)fwd_kernel, NWAVES * 64, LDS_BYTES) != hipSuccess || per_cu < 1) { fprintf(stderr, "kernel_launch: occupancy query says %d blocks/CU\n", per_cu); (void)hipGetLastError(); grid = -1; return; }
        grid = cus;
    }
    if (grid < 0) return;
    if (hipMemsetAsync((char*)d_ws + WS_CTL, 0, CTL_ZERO_BYTES, stream) != hipSuccess) return;
    Args a{};
    for (int i = 0; i < 22; ++i) a.in[i] = (const float*)d_in[i];
    a.out = (float*)d_out; a.ws = (unsigned char*)d_ws;
    for (int li = 0; li < N_LAUNCHES; ++li) {
        a.ph_lo = (N_LAUNCHES == 1) ? 0 : li; a.ph_hi = (N_LAUNCHES == 1) ? N_PHASES : li + 1; a.li = li;
        hipLaunchKernelGGL(fwd_kernel, dim3(grid), dim3(NWAVES * 64), LDS_BYTES, stream, a);
        if (N_LAUNCHES != 1 && li == REP_PHASE) { a.pad = REP_SUB; hipLaunchKernelGGL(fwd_kernel, dim3(grid), dim3(NWAVES * 64), LDS_BYTES, stream, a); a.pad = 0; }
    }
}
```
